# Optimizing an MI355X kernel written in HIP

```python
import jax, jax.numpy as jnp
from jax import lax
import numpy as np

D_MODEL = 1024
BATCH = 8
SEQ = 4096
DEPTH = 1

MIX_WIDTH = D_MODEL
RET_WIDTH = MIX_WIDTH // 2
MOBA_WIDTH = MIX_WIDTH - RET_WIDTH
HEAD_DIM = 128
RET_HEADS = RET_WIDTH // HEAD_DIM
MOBA_HEADS = MOBA_WIDTH // HEAD_DIM
RET_CHUNK = 128
MOBA_BLOCK = 256
MOBA_TOPK = 3
MOBA_QCHUNK = 32
D_FF = -(-8 * D_MODEL // (3 * 256)) * 256
IN_COLS = 4 * RET_WIDTH + 3 * MOBA_WIDTH
IN_SPLITS = (RET_WIDTH, 2 * RET_WIDTH, 3 * RET_WIDTH, 4 * RET_WIDTH,
             4 * RET_WIDTH + MOBA_WIDTH, 4 * RET_WIDTH + 2 * MOBA_WIDTH)
N_ADA = 6
DEEPNORM_ALPHA = (2 * DEPTH) ** 0.25
DEEPNORM_BETA = (8 * DEPTH) ** -0.25
LN_EPS = 1e-5

kernel_name = "hybrid_retention_moba_adaln_deepnorm"


def layer_norm(x, w=None, b=None):
    xf = x.astype(jnp.float32)
    mu = jnp.mean(xf, axis=-1, keepdims=True)
    var = jnp.mean(jnp.square(xf - mu), axis=-1, keepdims=True)
    y = (xf - mu) * lax.rsqrt(var + LN_EPS)
    if w is not None:
        y = y * w.astype(jnp.float32) + b.astype(jnp.float32)
    return y.astype(x.dtype)


def retention(q, k, v, g):
    B, T, H, d = q.shape
    C = RET_CHUNK
    N = T // C
    lg = jnp.log(1.0 - 2.0 ** (-5.0 - jnp.arange(H, dtype=jnp.float32)))
    pos = jnp.arange(C, dtype=jnp.float32)
    rel = pos[:, None] - pos[None, :]
    intra_decay = jnp.where(rel >= 0, jnp.exp(jnp.maximum(rel, 0.0)[None] * lg[:, None, None]), 0.0)
    q_decay = jnp.exp((pos + 1.0)[None] * lg[:, None])
    k_decay = jnp.exp((C - 1.0 - pos)[None] * lg[:, None])
    chunk_decay = jnp.exp(C * lg)

    def chunks(a):
        return a.reshape(B, N, C, H, d).transpose(0, 3, 1, 2, 4)

    qc, kc, vc = chunks(q), chunks(k * (d ** -0.5)), chunks(v)
    s = jnp.einsum('bhncd,bhnsd->bhncs', qc, kc) * intra_decay[:, None]
    intra = jnp.einsum('bhncs,bhnsd->bhncd', s, vc)
    kv = jnp.einsum('bhnsd,bhnse->nbhde', kc * k_decay[:, None, :, None], vc)

    def step(state, kv_n):
        return chunk_decay[:, None, None] * state + kv_n, state

    _, prev = lax.scan(step, jnp.zeros(kv.shape[1:], kv.dtype), kv)
    inter = jnp.einsum('bhncd,nbhde->bhnce', qc * q_decay[:, None, :, None], prev)
    y = (intra + inter).transpose(0, 2, 3, 1, 4).reshape(B, T, H, d)
    y = layer_norm(y).reshape(B, T, H * d)
    return jax.nn.silu(g) * y


def moba_attention(q, k, v):
    B, T, H, d = q.shape
    L = MOBA_BLOCK
    NB = -(-T // L)
    Tp = NB * L
    QC = MOBA_QCHUNK
    K_SEL = min(MOBA_TOPK, NB - 1)
    scale = d ** -0.5
    slopes = 2.0 ** (-8.0 * (jnp.arange(H, dtype=jnp.float32) + 1.0) / H)
    q = q.transpose(0, 2, 1, 3)
    pad = ((0, 0), (0, 0), (0, Tp - T), (0, 0))
    k = jnp.pad(k.transpose(0, 2, 1, 3), pad)
    v = jnp.pad(v.transpose(0, 2, 1, 3), pad)
    k_blocks = k.reshape(B, H, NB, L, d)
    v_blocks = v.reshape(B, H, NB, L, d)
    k_mean = jnp.mean(k_blocks, axis=3)
    bi = jnp.arange(B)[:, None, None, None]
    hi = jnp.arange(H)[None, :, None, None]
    offs = jnp.arange(L)

    def chunk(i):
        t0 = i * QC
        blk = t0 // L
        t = t0 + jnp.arange(QC)
        q_c = lax.dynamic_slice_in_dim(q, t0, QC, axis=2)
        k_own = lax.dynamic_slice_in_dim(k, blk * L, L, axis=2)
        v_own = lax.dynamic_slice_in_dim(v, blk * L, L, axis=2)
        dist_own = (t[:, None] - (blk * L + offs)[None, :]).astype(jnp.float32)
        s_own = (jnp.einsum('bhqd,bhsd->bhqs', q_c, k_own).astype(jnp.float32) * scale
                 - slopes[:, None, None] * dist_own)
        s_own = jnp.where(dist_own >= 0, s_own, -jnp.inf)
        if K_SEL > 0:
            gate = jnp.einsum('bhqd,bhnd->bhqn', q_c, k_mean).astype(jnp.float32)
            gate = jnp.where(jnp.arange(NB) < blk, gate, -jnp.inf)
            _, idx = lax.top_k(gate, K_SEL)
            k_sel = k_blocks[bi, hi, idx]
            v_sel = v_blocks[bi, hi, idx]
            dist_sel = (t[:, None, None] - (idx[..., None] * L + offs)).astype(jnp.float32)
            s_sel = (jnp.einsum('bhqd,bhqksd->bhqks', q_c, k_sel).astype(jnp.float32) * scale
                     - slopes[:, None, None, None] * dist_sel)
            valid = (jnp.arange(K_SEL) < blk)[:, None]
            s_sel = jnp.where(valid, s_sel, -jnp.inf).reshape(B, H, QC, K_SEL * L)
            p = jax.nn.softmax(jnp.concatenate([s_sel, s_own], axis=-1), axis=-1).astype(v.dtype)
            p_sel = p[..., :K_SEL * L].reshape(B, H, QC, K_SEL, L)
            p_own = p[..., K_SEL * L:]
            out = (jnp.einsum('bhqks,bhqksd->bhqd', p_sel, v_sel)
                   + jnp.einsum('bhqs,bhsd->bhqd', p_own, v_own))
        else:
            p_own = jax.nn.softmax(s_own, axis=-1).astype(v.dtype)
            out = jnp.einsum('bhqs,bhsd->bhqd', p_own, v_own)
        return out

    out = lax.map(chunk, jnp.arange(T // QC))
    return out.transpose(1, 0, 3, 2, 4).reshape(B, T, H * d)


def setup_inputs(seed: int = 0) -> dict:
    key = jax.random.key(seed)
    ks = jax.random.split(key, 12)
    f32 = jnp.float32
    x = jax.random.normal(ks[0], (BATCH, SEQ, D_MODEL), f32)
    c = jax.random.normal(ks[1], (BATCH, D_MODEL), f32)
    w_ada = jax.random.normal(ks[2], (DEPTH, D_MODEL, N_ADA * D_MODEL), f32) * D_MODEL ** -0.5
    b_ada = 0.02 * jax.random.normal(ks[3], (DEPTH, N_ADA * D_MODEL), f32)
    col_scale = jnp.concatenate([
        jnp.ones((2 * RET_WIDTH,), f32), jnp.full((RET_WIDTH,), DEEPNORM_BETA, f32),
        jnp.ones((RET_WIDTH + 2 * MOBA_WIDTH,), f32), jnp.full((MOBA_WIDTH,), DEEPNORM_BETA, f32)])
    w_in = jax.random.normal(ks[4], (DEPTH, D_MODEL, IN_COLS), f32) * D_MODEL ** -0.5 * col_scale
    w_out = jax.random.normal(ks[5], (DEPTH, MIX_WIDTH, D_MODEL), f32) * MIX_WIDTH ** -0.5 * DEEPNORM_BETA
    ln1_w = 1.0 + 0.02 * jax.random.normal(ks[6], (DEPTH, D_MODEL), f32)
    ln1_b = 0.02 * jax.random.normal(ks[7], (DEPTH, D_MODEL), f32)
    w_ffn_in = jax.random.normal(ks[8], (DEPTH, D_MODEL, 2 * D_FF), f32) * D_MODEL ** -0.5
    w_ffn_out = jax.random.normal(ks[9], (DEPTH, D_FF, D_MODEL), f32) * D_FF ** -0.5 * DEEPNORM_BETA
    ln2_w = 1.0 + 0.02 * jax.random.normal(ks[10], (DEPTH, D_MODEL), f32)
    ln2_b = 0.02 * jax.random.normal(ks[11], (DEPTH, D_MODEL), f32)
    return {"x": x, "c": c, "w_ada": w_ada, "b_ada": b_ada, "w_in": w_in, "w_out": w_out,
            "ln1_w": ln1_w, "ln1_b": ln1_b, "w_ffn_in": w_ffn_in, "w_ffn_out": w_ffn_out,
            "ln2_w": ln2_w, "ln2_b": ln2_b}


def reference(x, c, w_ada, b_ada, w_in, w_out, ln1_w, ln1_b, w_ffn_in, w_ffn_out, ln2_w, ln2_b):
    B, T, _ = x.shape
    for l in range(DEPTH):
        mod = jax.nn.silu(c) @ w_ada[l] + b_ada[l]
        sh1, sc1, g1, sh2, sc2, g2 = [m[:, None, :] for m in jnp.split(mod, N_ADA, axis=-1)]
        h = layer_norm(x) * (1.0 + sc1) + sh1
        proj = h @ w_in[l]
        rq, rk, rv, rg, mq, mk, mv = jnp.split(proj, IN_SPLITS, axis=-1)
        y_ret = retention(rq.reshape(B, T, RET_HEADS, HEAD_DIM), rk.reshape(B, T, RET_HEADS, HEAD_DIM),
                          rv.reshape(B, T, RET_HEADS, HEAD_DIM), rg)
        y_moba = moba_attention(mq.reshape(B, T, MOBA_HEADS, HEAD_DIM), mk.reshape(B, T, MOBA_HEADS, HEAD_DIM),
                                mv.reshape(B, T, MOBA_HEADS, HEAD_DIM))
        mix = jnp.concatenate([y_ret, y_moba], axis=-1) @ w_out[l]
        x = layer_norm(DEEPNORM_ALPHA * x + g1 * mix, ln1_w[l], ln1_b[l])
        h = layer_norm(x) * (1.0 + sc2) + sh2
        gate, up = jnp.split(h @ w_ffn_in[l], 2, axis=-1)
        ffn = (jax.nn.silu(gate) * up) @ w_ffn_out[l]
        x = layer_norm(DEEPNORM_ALPHA * x + g2 * ffn, ln2_w[l], ln2_b[l])
    return x
```

```cpp
#include <hip/hip_runtime.h>
#include <cstdio>
#include <cstdint>
#include <cmath>
namespace pg8 {
#define PG8_LAS __attribute__((address_space(3)))
typedef unsigned short bf16_t;
typedef short bf16x8 __attribute__((ext_vector_type(8)));
typedef float f32x4 __attribute__((ext_vector_type(4)));
typedef unsigned u32x4 __attribute__((ext_vector_type(4)));
constexpr int BM = 256, BK = 64, HALF = 128, HTB = HALF * BK * 2  , STAGE_BYTES = 8 * HTB, NXCD = 8, WGM = 8;

__host__ __device__ __forceinline__ int lds_byte(int r, int c) { const int st = (r >> 4) * 2 + (c >> 5), rr = r & 15, cc = c & 31, ob = rr * 64 + cc * 2; return st * 1024 + (ob ^ (((ob >> 9) & 1) << 5)); }
__host__ __device__ __forceinline__ void stage_rc(int b, int& R, int& C) { const int st = b / 1024, sb = b % 1024, swz = sb ^ (((sb >> 9) & 1) << 5); R = (st >> 1) * 16 + swz / 64; C = (st & 1) * 32 + (swz % 64) / 2; }
__host__ __device__ __forceinline__ int perm32(int rho) { const int n = rho >> 4, i = rho & 15; return 8 * (i >> 2) + 4 * n + (i & 3); }

struct Unit { int pm, pn; };
struct Gemm { const bf16_t* A; const bf16_t* Bt; int M, N, K; };

struct StaticOrder {
    int nM, nN, nwg, G, c;
    __host__ __device__ void init(int M, int N, int G_, int c_) { nM = M / BM; nN = N / BM; nwg = nM * nN; G = G_; c = c_; }
    __host__ __device__ bool next(int i, Unit& u) const {
        const long L = (long)i * G + c; if (L >= nwg) return false;
        int wgid = (int)L; { const int q = nwg / NXCD, r = nwg % NXCD, xcd = wgid % NXCD, off = wgid / NXCD; wgid = (xcd < r ? xcd * (q + 1) : r * (q + 1) + (xcd - r) * q) + off; }
        const int nig = WGM * nN, gid = wgid / nig, fm = gid * WGM, gsz = (nM - fm) < WGM ? (nM - fm) : WGM;
        u.pm = fm + ((wgid % nig) % gsz); u.pn = (wgid % nig) / gsz; return true;
    }
    __device__ __forceinline__ void a_ready(const Unit&) const {}
    __device__ __forceinline__ void done(const Unit&) const {}
};

__device__ __forceinline__ unsigned cvt_pk_bf16(float lo, float hi) { unsigned r; asm volatile("v_cvt_pk_bf16_f32 %0, %1, %2" : "=v"(r) : "v"(lo), "v"(hi)); return r; }
typedef float f32x2 __attribute__((ext_vector_type(2)));
struct EpiProj {
    static constexpr bool PERM = true, AFTER_DRAIN = false;
    bf16_t* O; int ldc; float s_rk, s_mq;
    __device__ __forceinline__ void operator()(const f32x4 (&acc)[2][2][4][2], const Unit& u, int wr, int wc, int fr, int fq) const {
        const int row0 = u.pm * BM + wr * 64 + fr, col0 = u.pn * BM + wc * 32 + 8 * fq;
        const float sc = (u.pn == 2 || u.pn == 3) ? s_rk : ((u.pn == 8 || u.pn == 9) ? s_mq : 1.0f);
#pragma unroll
        for (int ai = 0; ai < 2; ++ai)
#pragma unroll
            for (int m = 0; m < 4; ++m) { bf16_t* rowp = O + (size_t)(row0 + ai * HALF + m * 16) * ldc + col0;
#pragma unroll
                for (int bj = 0; bj < 2; ++bj) { const f32x4 v0 = acc[ai][bj][m][0] * sc, v1 = acc[ai][bj][m][1] * sc;
                    u32x4 w; w.x = cvt_pk_bf16(v0[0], v0[1]); w.y = cvt_pk_bf16(v0[2], v0[3]); w.z = cvt_pk_bf16(v1[0], v1[1]); w.w = cvt_pk_bf16(v1[2], v1[3]);
                    *(u32x4*)(rowp + bj * HALF) = w; } }
    }
};
struct EpiRes {
    static constexpr bool PERM = false, AFTER_DRAIN = false;
    const float* base; float* out; const float* gate; int gate_stride; float alpha;
    __device__ __forceinline__ void operator()(const f32x4 (&acc)[2][2][4][2], const Unit& u, int wr, int wc, int fr, int fq) const {
        const int row0 = u.pm * BM + wr * 64 + fr, col0 = u.pn * BM + wc * 32 + 4 * fq;
        const float* g = gate + (size_t)(u.pm >> 4) * gate_stride + col0;
        f32x4 gv[2][2];
#pragma unroll
        for (int bj = 0; bj < 2; ++bj)
#pragma unroll
            for (int n = 0; n < 2; ++n) gv[bj][n] = *(const f32x4*)(g + bj * HALF + n * 16);
#pragma unroll
        for (int ai = 0; ai < 2; ++ai)
#pragma unroll
            for (int m = 0; m < 4; ++m) { const size_t off = (size_t)(row0 + ai * HALF + m * 16) * 1024 + col0;
#pragma unroll
                for (int bj = 0; bj < 2; ++bj)
#pragma unroll
                    for (int n = 0; n < 2; ++n) { const f32x4 bs = *(const f32x4*)(base + off + bj * HALF + n * 16);
                        *(f32x4*)(out + off + bj * HALF + n * 16) = bs * alpha + gv[bj][n] * acc[ai][bj][m][n]; }
                if (m & 1) asm volatile("" ::: "memory"); }
    }
};
struct EpiSwiGLU {
    static constexpr bool PERM = true, AFTER_DRAIN = false;
    bf16_t* O; int ldc;
    __device__ __forceinline__ void operator()(const f32x4 (&acc)[2][2][4][2], const Unit& u, int wr, int wc, int fr, int fq) const {
        const int row0 = u.pm * BM + wr * 64 + fr, col0 = u.pn * HALF + wc * 32 + 8 * fq;
#pragma unroll
        for (int ai = 0; ai < 2; ++ai)
#pragma unroll
            for (int m = 0; m < 4; ++m) { bf16_t* rowp = O + (size_t)(row0 + ai * HALF + m * 16) * ldc + col0;
                float h[8];
#pragma unroll
                for (int n = 0; n < 2; ++n)
#pragma unroll
                    for (int i = 0; i < 4; ++i) { const float gt = acc[ai][0][m][n][i], up = acc[ai][1][m][n][i];
                        h[n * 4 + i] = gt * __builtin_amdgcn_rcpf(1.0f + __builtin_amdgcn_exp2f(-1.4426950408889634f * gt)) * up; }
                u32x4 w; w.x = cvt_pk_bf16(h[0], h[1]); w.y = cvt_pk_bf16(h[2], h[3]); w.z = cvt_pk_bf16(h[4], h[5]); w.w = cvt_pk_bf16(h[6], h[7]);
                *(u32x4*)rowp = w; }
    }
};
template <class Epi, class Sched, bool ALIGN_EPI = false, bool SP2 = false>
__device__ __forceinline__ void gemm_phase(PG8_LAS unsigned char* lds, const Gemm g, const Sched& S, const Epi& E) {
    const int tid = threadIdx.x, wid = __builtin_amdgcn_readfirstlane(tid >> 6), lane = tid & 63, wr = wid >> 2, wc = wid & 3, fr = lane & 15, fq = lane >> 4;
    const int K = g.K, nt = K / BK;
    unsigned voffA[2], voffB[2];
#pragma unroll
    for (int i = 0; i < 2; ++i) { int R, C; stage_rc(tid * 16 + i * 8192, R, C); const int Rb = Epi::PERM ? ((R & ~31) + perm32(R & 31)) : R;
        voffA[i] = (unsigned)(R * K + C) * 2u; voffB[i] = (unsigned)(Rb * K + C) * 2u; }
    const size_t kstep = (size_t)(BK * 2);
    const size_t hstep = (size_t)HALF * K * 2;
    const size_t tstep = 2 * hstep;
    const unsigned ldsw = (unsigned)wid * 1024u;
    const int aoff = lds_byte(wr * 64 + fr, fq * 8), boff = lds_byte(wc * 32 + fr, fq * 8);
#define PG8_SA(b, h) (((b) * 2 + (h)) * HTB)
#define PG8_SB(b, h) ((4 + (b) * 2 + (h)) * HTB)
#define PG8_STAGE(bufoff, gbase, voff) do { _Pragma("unroll") for (int _i = 0; _i < 2; ++_i) \
        __builtin_amdgcn_global_load_lds((const unsigned*)((const char*)(gbase) + (voff)[_i]), (PG8_LAS unsigned*)(lds + (bufoff) + ldsw + _i * 8192), 16, 0, 0); } while (0)
#define PG8_LDA(dst, b, h) do { _Pragma("unroll") for (int m = 0; m < 4; ++m) _Pragma("unroll") for (int k = 0; k < 2; ++k) dst[m][k] = *(const PG8_LAS bf16x8*)(lds + PG8_SA(b, h) + aoff + m * 2048 + k * 1024); } while (0)
#define PG8_LDB(dst, b, h) do { _Pragma("unroll") for (int n = 0; n < 2; ++n) _Pragma("unroll") for (int k = 0; k < 2; ++k) dst[n][k] = *(const PG8_LAS bf16x8*)(lds + PG8_SB(b, h) + boff + n * 2048 + k * 1024); } while (0)
#define PG8_MMA(ai, bj, At, Bt) do { __builtin_amdgcn_s_setprio(1); _Pragma("unroll") for (int m = 0; m < 4; ++m) _Pragma("unroll") for (int n = 0; n < 2; ++n) _Pragma("unroll") for (int k = 0; k < 2; ++k) \
        acc[ai][bj][m][n] = __builtin_amdgcn_mfma_f32_16x16x32_bf16(Bt[n][k], At[m][k], acc[ai][bj][m][n], 0, 0, 0); __builtin_amdgcn_s_setprio(0); } while (0)
#define PG8_WAIT_V(n) asm volatile("s_waitcnt vmcnt(" #n ")" ::: "memory")
#define PG8_WAIT_L(n) asm volatile("s_waitcnt lgkmcnt(" #n ")" ::: "memory")
#define PG8_BAR __builtin_amdgcn_s_barrier()
#define PG8_SCHED __builtin_amdgcn_sched_barrier(0)
    Unit cur, nxt; int ui = 0;
    if (!S.next(0, cur)) return;
    f32x4 acc[2][2][4][2];
#pragma unroll
    for (int a = 0; a < 2; ++a)
#pragma unroll
        for (int b = 0; b < 2; ++b)
#pragma unroll
            for (int m = 0; m < 4; ++m)
#pragma unroll
                for (int n = 0; n < 2; ++n) acc[a][b][m][n] = (f32x4){0.f, 0.f, 0.f, 0.f};
    bf16x8 At[4][2], B0[2][2], B1[2][2];
    const char* cA = (const char*)g.A + (size_t)cur.pm * tstep; const char* cB = (const char*)g.Bt + (size_t)cur.pn * tstep;
    S.a_ready(cur);
    if constexpr (SP2) {
        PG8_STAGE(PG8_SB(0, 0), cB, voffB); PG8_STAGE(PG8_SB(0, 1), cB + hstep, voffB); PG8_STAGE(PG8_SA(0, 0), cA, voffA); PG8_STAGE(PG8_SA(0, 1), cA + hstep, voffA);
        if (wr == 1) PG8_BAR;
        PG8_WAIT_V(2); PG8_BAR;
        PG8_STAGE(PG8_SB(1, 0), cB + kstep, voffB); PG8_STAGE(PG8_SA(1, 0), cA + kstep, voffA); PG8_STAGE(PG8_SB(1, 1), cB + hstep + kstep, voffB);
        PG8_WAIT_V(6); PG8_BAR;
    } else {
        PG8_STAGE(PG8_SB(0, 0), cB, voffB); PG8_STAGE(PG8_SA(0, 0), cA, voffA); PG8_STAGE(PG8_SB(0, 1), cB + hstep, voffB); PG8_STAGE(PG8_SA(0, 1), cA + hstep, voffA);
        if (wr == 1) PG8_BAR;
        PG8_WAIT_V(4); PG8_BAR;
        PG8_STAGE(PG8_SB(1, 0), cB + kstep, voffB); PG8_STAGE(PG8_SA(1, 0), cA + kstep, voffA); PG8_STAGE(PG8_SB(1, 1), cB + hstep + kstep, voffB);
        PG8_WAIT_V(6); PG8_BAR;
    }
    for (;;) {
        const bool has_next = S.next(ui + 1, nxt);
        const char* nA = has_next ? (const char*)g.A + (size_t)nxt.pm * tstep : cA; const char* nB = has_next ? (const char*)g.Bt + (size_t)nxt.pn * tstep : cB;
        for (int t = 0; t < nt; t += 2) {
            const bool last = (t == nt - 2);
            const char* a1 = cA + (size_t)(t + 1) * kstep;
            const char* a2 = last ? nA : cA + (size_t)(t + 2) * kstep; const char* b2 = last ? nB : cB + (size_t)(t + 2) * kstep;
            const char* a3 = a2 + kstep; const char* b3 = b2 + kstep;
            if (last && has_next) S.a_ready(nxt);
            if constexpr (SP2) {
            PG8_LDB(B0, 0, 0); PG8_LDB(B1, 0, 1); PG8_SCHED; PG8_LDA(At, 0, 0); PG8_STAGE(PG8_SA(1, 1), a1 + hstep, voffA);
            PG8_WAIT_V(8); PG8_WAIT_L(0); PG8_BAR; PG8_MMA(0, 0, At, B0); PG8_MMA(0, 1, At, B1); PG8_BAR; PG8_SCHED;
            PG8_LDA(At, 0, 1); PG8_STAGE(PG8_SB(0, 0), b2, voffB); PG8_STAGE(PG8_SB(0, 1), b2 + hstep, voffB); PG8_STAGE(PG8_SA(0, 0), a2, voffA);
            PG8_WAIT_V(8); PG8_WAIT_L(0); PG8_BAR; PG8_MMA(1, 0, At, B0); PG8_MMA(1, 1, At, B1); PG8_BAR; PG8_SCHED;
            PG8_LDB(B0, 1, 0); PG8_LDB(B1, 1, 1); PG8_SCHED; PG8_LDA(At, 1, 0); PG8_STAGE(PG8_SA(0, 1), a2 + hstep, voffA);
            PG8_WAIT_V(8); PG8_WAIT_L(0); PG8_BAR; PG8_MMA(0, 0, At, B0); PG8_MMA(0, 1, At, B1); PG8_BAR; PG8_SCHED;
            PG8_LDA(At, 1, 1); PG8_STAGE(PG8_SB(1, 0), b3, voffB); PG8_STAGE(PG8_SB(1, 1), b3 + hstep, voffB); PG8_STAGE(PG8_SA(1, 0), a3, voffA);
            PG8_WAIT_V(8); PG8_WAIT_L(0); PG8_BAR; PG8_MMA(1, 0, At, B0); PG8_MMA(1, 1, At, B1); PG8_BAR; PG8_SCHED;
            } else {
            PG8_LDB(B0, 0, 0); PG8_SCHED; PG8_LDA(At, 0, 0); PG8_STAGE(PG8_SA(1, 1), a1 + hstep, voffA);
            PG8_WAIT_L(8); PG8_BAR; PG8_WAIT_L(0); PG8_MMA(0, 0, At, B0); PG8_BAR; PG8_SCHED;
            PG8_LDB(B1, 0, 1); PG8_STAGE(PG8_SB(0, 0), b2, voffB);
            PG8_BAR; PG8_WAIT_L(0); PG8_MMA(0, 1, At, B1); PG8_BAR;
            PG8_LDA(At, 0, 1); PG8_STAGE(PG8_SA(0, 0), a2, voffA);
            PG8_BAR; PG8_WAIT_L(0); PG8_MMA(1, 0, At, B0); PG8_BAR; PG8_SCHED;
            PG8_STAGE(PG8_SB(0, 1), b2 + hstep, voffB);
            PG8_WAIT_V(6); PG8_BAR; PG8_MMA(1, 1, At, B1); PG8_BAR;
            PG8_LDB(B0, 1, 0); PG8_SCHED; PG8_LDA(At, 1, 0); PG8_STAGE(PG8_SA(0, 1), a2 + hstep, voffA);
            PG8_WAIT_L(8); PG8_BAR; PG8_WAIT_L(0); PG8_MMA(0, 0, At, B0); PG8_BAR; PG8_SCHED;
            PG8_LDB(B1, 1, 1); PG8_STAGE(PG8_SB(1, 0), b3, voffB);
            PG8_BAR; PG8_WAIT_L(0); PG8_MMA(0, 1, At, B1); PG8_BAR;
            PG8_LDA(At, 1, 1); PG8_STAGE(PG8_SA(1, 0), a3, voffA);
            PG8_BAR; PG8_WAIT_L(0); PG8_MMA(1, 0, At, B0); PG8_BAR; PG8_SCHED;
            PG8_STAGE(PG8_SB(1, 1), b3 + hstep, voffB);
            PG8_WAIT_V(6); PG8_BAR; PG8_MMA(1, 1, At, B1); PG8_BAR;
            }
        }
        if constexpr (ALIGN_EPI) { if (wr == 0) PG8_BAR; }
        if constexpr (!Epi::AFTER_DRAIN) { E(acc, cur, wr, wc, fr, fq); S.done(cur); }
        if (!has_next) break;
#pragma unroll
        for (int a = 0; a < 2; ++a)
#pragma unroll
            for (int b = 0; b < 2; ++b)
#pragma unroll
                for (int m = 0; m < 4; ++m)
#pragma unroll
                    for (int n = 0; n < 2; ++n) acc[a][b][m][n] = (f32x4){0.f, 0.f, 0.f, 0.f};
        cur = nxt; cA = nA; cB = nB; ++ui;
        if constexpr (ALIGN_EPI) { if (wr == 1) PG8_BAR; }
    }
    PG8_WAIT_V(0);
    if constexpr (!ALIGN_EPI) { if (wr == 0) PG8_BAR; }
    PG8_BAR;
    if constexpr (Epi::AFTER_DRAIN) { E.fused(acc, cur, wr, wc, fr, fq, lds, wid, lane); S.done(cur); }
#undef PG8_SA
#undef PG8_SB
#undef PG8_STAGE
#undef PG8_LDA
#undef PG8_LDB
#undef PG8_MMA
#undef PG8_WAIT_V
#undef PG8_WAIT_L
#undef PG8_BAR
#undef PG8_SCHED
}
}
#define GAS __attribute__((address_space(1)))
#define LAS __attribute__((address_space(3)))
typedef unsigned short bf16;
typedef unsigned v4u __attribute__((ext_vector_type(4)));
typedef float f32x4 __attribute__((ext_vector_type(4)));
typedef short bf16x8 __attribute__((ext_vector_type(8)));
typedef GAS unsigned gu32;
typedef GAS unsigned long long gu64;
#define RLX_AGENT __ATOMIC_RELAXED, __HIP_MEMORY_SCOPE_AGENT
#define LDS_WAIT() asm volatile("s_waitcnt lgkmcnt(0)" ::: "memory")
#define VM_WAIT() asm volatile("s_waitcnt vmcnt(0)" ::: "memory")
__device__ __forceinline__ unsigned long long rt() { return __builtin_amdgcn_s_memrealtime(); }
__device__ __forceinline__ unsigned f2bf(float f) { unsigned u = __builtin_bit_cast(unsigned, f); return (u + 0x7fffu + ((u >> 16) & 1u)) >> 16; }
__device__ __forceinline__ unsigned pk2(float lo, float hi) { return f2bf(lo) | (f2bf(hi) << 16); }
#define XB_TMO      128
#define XB_XCNT(j)  (256  + 64 * (j))
#define XB_XSUB(j)  (1280 + 64 * (j))
#define XB_XGEN(j)  (2304 + 64 * (j))
#define XB_TOP      3328
#define XB_TOPGEN   3392
#define XCD_BAR_WORDS 3456
#define XB_SPIN_CAP (1u << 18)

__device__ __forceinline__ unsigned xb_ld(unsigned* p)              { return __hip_atomic_load(p, __ATOMIC_RELAXED, __HIP_MEMORY_SCOPE_AGENT); }
__device__ __forceinline__ unsigned xb_add(unsigned* p, unsigned v) { return __hip_atomic_fetch_add(p, v, __ATOMIC_RELAXED, __HIP_MEMORY_SCOPE_AGENT); }
__device__ __forceinline__ unsigned xb_xcc_id() { return (unsigned)__builtin_amdgcn_s_getreg((3 << 11) | 20) & 0xFu; }
#define XB_SPIN(cond, bar) do { unsigned _sp = 0; while (cond) { __builtin_amdgcn_s_sleep(1); \
    if ((++_sp & 255u) == 0u) { if (xb_ld(&(bar)[XB_TMO])) break; if (_sp > XB_SPIN_CAP) { atomicAdd(&(bar)[XB_TMO], 1u); break; } } } } while (0)

struct XcdBarrier {
    unsigned* bar; unsigned x;
    volatile LAS unsigned* st;
};

__device__ __forceinline__ XcdBarrier xcd_barrier_post(unsigned* bar, volatile LAS unsigned* st) {
    XcdBarrier b; b.bar = bar; b.x = xb_xcc_id(); b.st = st;
    if (threadIdx.x == 0) (void)xb_add(&bar[XB_XCNT(b.x)], 1u);
    return b;
}
__device__ __forceinline__ void xcd_barrier_complete(unsigned* bar, unsigned x, unsigned& nloc, unsigned& nx) {
    const unsigned G = gridDim.x * gridDim.y * gridDim.z;
    unsigned sum, cnt, mine, sp = 0u;
    for (;;) {
        sum = 0u; cnt = 0u; mine = 0u;
#pragma unroll
        for (unsigned j = 0; j < 16; ++j) { const unsigned c = xb_ld(&bar[XB_XCNT(j)]); sum += c; cnt += (c > 0u) ? 1u : 0u; mine = (j == x) ? c : mine; }
        if (sum == G) break;
        __builtin_amdgcn_s_sleep(1);
        if ((++sp & 255u) == 0u) { if (xb_ld(&bar[XB_TMO])) break; if (sp > XB_SPIN_CAP) { atomicAdd(&bar[XB_TMO], 1u); break; } }
    }
    nloc = mine > 0u ? mine : 1u; nx = cnt > 0u ? cnt : 1u;
}

__device__ __forceinline__ void xcd_barrier(const XcdBarrier& b) {
    asm volatile("s_waitcnt vmcnt(0)" ::: "memory");
    __syncthreads();
    if (threadIdx.x == 0) {
        unsigned* bar = b.bar;
        __builtin_amdgcn_s_waitcnt(0);
        unsigned nloc = b.st[0], nx = b.st[1];
        if (nloc == 0u) { xcd_barrier_complete(bar, b.x, nloc, nx); b.st[0] = nloc; b.st[1] = nx; }
        const unsigned old = xb_add(&bar[XB_XSUB(b.x)], 1u);
        const unsigned gen = old / nloc;
        if (old + 1u == (gen + 1u) * nloc) {
            __builtin_amdgcn_fence(__ATOMIC_RELEASE, "agent");
            asm volatile("s_waitcnt vmcnt(0)" ::: "memory");
            const unsigned og = xb_add(&bar[XB_TOP], 1u);
            const unsigned tg = og / nx;
            if (og + 1u == (tg + 1u) * nx) xb_add(&bar[XB_TOPGEN], 1u);
            else XB_SPIN(xb_ld(&bar[XB_TOPGEN]) == tg, bar);
            __builtin_amdgcn_fence(__ATOMIC_ACQUIRE, "agent");
            xb_add(&bar[XB_XGEN(b.x)], 1u);
            asm volatile("s_waitcnt vmcnt(0)" ::: "memory");
        } else {
            XB_SPIN(xb_ld(&bar[XB_XGEN(b.x)]) == gen, bar);
            __builtin_amdgcn_fence(__ATOMIC_ACQUIRE, "agent");
            asm volatile("s_waitcnt vmcnt(0)" ::: "memory");
        }
    }
    __syncthreads();
}
__device__ __forceinline__ float wave_sum(float v) {
#pragma unroll
    for (int o = 1; o < 64; o <<= 1) v += __shfl_xor(v, o);
    return v;
}
__device__ __forceinline__ void p0_transpose_item(const float* W, int K, int N, bf16* WT, int row_off, LAS float* scr, int item, int lane) {
    const int nblk = N / 32, kb = item / nblk, nb = item % nblk, k0 = 64 * kb, n0 = 32 * nb;
#pragma unroll 8
    for (int i = 0; i < 32; ++i) { const int kk = 2 * i + (lane >> 5); scr[kk * 33 + (lane & 31)] = W[(size_t)(k0 + kk) * N + n0 + (lane & 31)]; }
    LDS_WAIT(); asm volatile("" ::: "memory");
    const int c = lane & 7;
#pragma unroll
    for (int j = 0; j < 4; ++j) { const int n = (lane >> 3) + 8 * j; const LAS float* s = scr + (8 * c) * 33 + n;
        v4u o; o.x = pk2(s[0 * 33], s[1 * 33]); o.y = pk2(s[2 * 33], s[3 * 33]); o.z = pk2(s[4 * 33], s[5 * 33]); o.w = pk2(s[6 * 33], s[7 * 33]);
        *(GAS v4u*)(WT + (size_t)(row_off + n0 + n) * K + k0 + 8 * c) = o; }
    LDS_WAIT(); asm volatile("" ::: "memory");
}

constexpr int NWAVES = 8;
constexpr int BATCH = 8, SEQ = 4096, DM = 1024, M = BATCH * SEQ;
constexpr int NPROJ = 3584, DFF = 2816, NFI = 2 * DFF, NADA = 6 * DM;
constexpr int C_RQ = 0, C_RK = 512, C_RV = 1024, C_RG = 1536, C_MQ = 2048, C_MK = 2560, C_MV = 3072;
constexpr int NH = 4, HD = 128, NBLK = 16, LBLK = 256;
constexpr float LN_EPS = 1e-5f;
constexpr float ALPHA = 1.189207115002721f;
constexpr float RSQD = 0.08838834764831845f;
constexpr float LOG2E = 1.4426950408889634f;
constexpr int MOD_SH1 = 0, MOD_SC1 = 1024, MOD_G1 = 2048, MOD_SH2 = 3072, MOD_SC2 = 4096, MOD_G2 = 5120;

constexpr size_t MiB = 1u << 20;
constexpr size_t WS_CTL = 0, CTL_ZERO_BYTES = 1 * MiB;
constexpr size_t WS_MOD = 1 * MiB;
constexpr size_t WS_KMEAN = 1 * MiB + 256 * 1024;
constexpr size_t WS_WIN = 2 * MiB, WS_WOUT = 9 * MiB, WS_WFI = 11 * MiB, WS_WFO = 22 * MiB;
constexpr size_t WS_H1 = 32 * MiB;
constexpr size_t WS_PROJ = 96 * MiB;
constexpr size_t WS_HID = 96 * MiB;
constexpr size_t WS_Y = 320 * MiB;
constexpr size_t WS_H2 = 384 * MiB;
constexpr size_t WS_END = 448 * MiB;
constexpr int CW_TMO = 0, CW_CODE = 1, CW_BAR = 4096;

constexpr int RING_OFF = 0, RING_BYTES = 131072;
constexpr int LDSCTL_OFF = RING_BYTES, MISC_OFF = LDSCTL_OFF + 320;
constexpr int LDS_BYTES = 147456;

struct Frame {
    LAS unsigned char* lds;
    volatile LAS unsigned* MISC;
    gu32* ctl;
    int tid, lane, wave, G;
    const float *x, *c, *w_ada, *b_ada, *w_in, *w_out, *ln1_w, *ln1_b, *w_fi, *w_fo, *ln2_w, *ln2_b;
    float* out;
    float *MOD, *KMEAN;
    bf16 *WIN, *WOUT, *WFI, *WFO, *H1, *PROJ, *HID, *Y, *H2;
};

__device__ __forceinline__ float bf2f(unsigned u16) { return __uint_as_float(u16 << 16); }
__device__ __forceinline__ float wave_max(float v) {
#pragma unroll
    for (int o = 1; o < 64; o <<= 1) v = fmaxf(v, __shfl_xor(v, o));
    return v;
}
__device__ __forceinline__ float silu_f(float v) { return v * __builtin_amdgcn_rcpf(1.0f + __builtin_amdgcn_exp2f(-LOG2E * v)); }

__device__ __forceinline__ void p0_mod_item(Frame& F, int item) {
    LAS float* sl = (LAS float*)(F.lds);
    LAS float* red = (LAS float*)(F.lds + 32768);
    for (int i = F.tid; i < BATCH * DM; i += NWAVES * 64) { const int b = i >> 10, k = i & 1023; sl[k * 8 + b] = silu_f(F.c[i]); }
    __syncthreads();
    const int col = F.tid & 31, kg = F.tid >> 5, n = item * 32 + col;
    float a0 = 0.f, a1 = 0.f, a2 = 0.f, a3 = 0.f, a4 = 0.f, a5 = 0.f, a6 = 0.f, a7 = 0.f;
#pragma unroll 4
    for (int kk = 0; kk < 64; ++kk) { const int k = kg * 64 + kk; const float w = F.w_ada[(size_t)k * NADA + n];
        const f32x4 s0 = *(LAS f32x4*)(sl + k * 8), s1 = *(LAS f32x4*)(sl + k * 8 + 4);
        a0 += s0[0] * w; a1 += s0[1] * w; a2 += s0[2] * w; a3 += s0[3] * w; a4 += s1[0] * w; a5 += s1[1] * w; a6 += s1[2] * w; a7 += s1[3] * w; }
    red[(kg * 8 + 0) * 32 + col] = a0; red[(kg * 8 + 1) * 32 + col] = a1; red[(kg * 8 + 2) * 32 + col] = a2; red[(kg * 8 + 3) * 32 + col] = a3;
    red[(kg * 8 + 4) * 32 + col] = a4; red[(kg * 8 + 5) * 32 + col] = a5; red[(kg * 8 + 6) * 32 + col] = a6; red[(kg * 8 + 7) * 32 + col] = a7;
    __syncthreads();
    if (F.tid < 256) { const int b = F.tid >> 5, cc = F.tid & 31; float s = 0.f;
#pragma unroll
        for (int g = 0; g < 16; ++g) s += red[(g * 8 + b) * 32 + cc];
        F.MOD[b * NADA + item * 32 + cc] = s + F.b_ada[item * 32 + cc]; }
    __syncthreads();
}
__device__ __forceinline__ void p0_prologue(Frame& F) {
    for (int it = blockIdx.x; it < NADA / 32; it += F.G) p0_mod_item(F, it);
    LAS float* scr = (LAS float*)(F.lds + RING_OFF + F.wave * 16384);
    const int gw = blockIdx.x * NWAVES + F.wave, NGW = F.G * NWAVES;
    constexpr int I_IN = (DM / 64) * (NPROJ / 32), I_OUT = (DM / 64) * (DM / 32), I_FI = (DM / 64) * (NFI / 32), I_FO = (DFF / 64) * (DM / 32);
    constexpr int NITEMS = I_IN + I_OUT + I_FI + I_FO;
    for (int it = gw; it < NITEMS; it += NGW) {
        int r = it;
        if (r < I_IN) { p0_transpose_item(F.w_in, DM, NPROJ, F.WIN, 0, scr, r, F.lane); continue; } r -= I_IN;
        if (r < I_OUT) { p0_transpose_item(F.w_out, DM, DM, F.WOUT, 0, scr, r, F.lane); continue; } r -= I_OUT;
        if (r < I_FI) {
            const int nb = r % (NFI / 32), n0 = 32 * nb; const int isup = n0 >= DFF ? 1 : 0, j0 = n0 - isup * DFF;
            const int dst0 = 256 * (j0 >> 7) + 128 * isup + (j0 & 127);
            p0_transpose_item(F.w_fi, DM, NFI, F.WFI, dst0 - n0, scr, r, F.lane); continue; } r -= I_FI;
        p0_transpose_item(F.w_fo, DFF, DM, F.WFO, 0, scr, r, F.lane);
    }
}
__device__ __forceinline__ void row_stats(const f32x4 (&v)[4], float& mean, float& rstd) {
    float s = 0.f;
#pragma unroll
    for (int j = 0; j < 4; ++j) s += (v[j][0] + v[j][1]) + (v[j][2] + v[j][3]);
    mean = wave_sum(s) * (1.f / DM); float s2 = 0.f;
#pragma unroll
    for (int j = 0; j < 4; ++j) { const f32x4 d = v[j] - mean; s2 += (d[0] * d[0] + d[1] * d[1]) + (d[2] * d[2] + d[3] * d[3]); }
    rstd = 1.f / sqrtf(wave_sum(s2) * (1.f / DM) + LN_EPS);
}
__device__ __forceinline__ void p1_ln_mod(Frame& F) {
    const int gw = blockIdx.x * NWAVES + F.wave, NGW = F.G * NWAVES;
    for (int m = gw; m < M; m += NGW) {
        const float* mod = F.MOD + (size_t)(m >> 12) * NADA;
        const GAS f32x4* xr = (const GAS f32x4*)(F.x + (size_t)m * DM) + F.lane;
        f32x4 v[4];
#pragma unroll
        for (int j = 0; j < 4; ++j) v[j] = xr[64 * j];
        float mean, rstd; row_stats(v, mean, rstd);
        GAS unsigned long long* o8 = (GAS unsigned long long*)(F.H1 + (size_t)m * DM) + F.lane;
#pragma unroll
        for (int j = 0; j < 4; ++j) { const int col = 256 * j + 4 * F.lane;
            const f32x4 sc = *(const f32x4*)(mod + MOD_SC1 + col), sh = *(const f32x4*)(mod + MOD_SH1 + col);
            const f32x4 h = (v[j] - mean) * rstd * (sc + 1.0f) + sh;
            o8[64 * j] = (unsigned long long)pk2(h[0], h[1]) | ((unsigned long long)pk2(h[2], h[3]) << 32); }
    }
}
__device__ __forceinline__ void p7_ln_ln(Frame& F) {
    const int gw = blockIdx.x * NWAVES + F.wave, NGW = F.G * NWAVES;
    for (int m = gw; m < M; m += NGW) {
        const float* mod = F.MOD + (size_t)(m >> 12) * NADA;
        GAS f32x4* zr = (GAS f32x4*)(F.out + (size_t)m * DM) + F.lane;
        f32x4 v[4];
#pragma unroll
        for (int j = 0; j < 4; ++j) v[j] = zr[64 * j];
        float mean, rstd; row_stats(v, mean, rstd);
#pragma unroll
        for (int j = 0; j < 4; ++j) { const int col = 256 * j + 4 * F.lane;
            v[j] = (v[j] - mean) * rstd * *(const f32x4*)(F.ln1_w + col) + *(const f32x4*)(F.ln1_b + col); zr[64 * j] = v[j]; }
        row_stats(v, mean, rstd);
        GAS unsigned long long* o8 = (GAS unsigned long long*)(F.H2 + (size_t)m * DM) + F.lane;
#pragma unroll
        for (int j = 0; j < 4; ++j) { const int col = 256 * j + 4 * F.lane;
            const f32x4 sc = *(const f32x4*)(mod + MOD_SC2 + col), sh = *(const f32x4*)(mod + MOD_SH2 + col);
            const f32x4 h = (v[j] - mean) * rstd * (sc + 1.0f) + sh;
            o8[64 * j] = (unsigned long long)pk2(h[0], h[1]) | ((unsigned long long)pk2(h[2], h[3]) << 32); }
    }
}
__device__ __forceinline__ void p10_ln_final(Frame& F) {
    const int gw = blockIdx.x * NWAVES + F.wave, NGW = F.G * NWAVES;
    for (int m = gw; m < M; m += NGW) {
        GAS f32x4* zr = (GAS f32x4*)(F.out + (size_t)m * DM) + F.lane;
        f32x4 v[4];
#pragma unroll
        for (int j = 0; j < 4; ++j) v[j] = zr[64 * j];
        float mean, rstd; row_stats(v, mean, rstd);
#pragma unroll
        for (int j = 0; j < 4; ++j) { const int col = 256 * j + 4 * F.lane;
            zr[64 * j] = (v[j] - mean) * rstd * *(const f32x4*)(F.ln2_w + col) + *(const f32x4*)(F.ln2_b + col); }
    }
}
__device__ __forceinline__ void p3_kmean(Frame& F) {
    LAS float* red = (LAS float*)F.lds;
    const int d = F.tid & 127, rg = F.tid >> 7;
    for (int it = blockIdx.x; it < BATCH * NH * NBLK; it += F.G) {
        const int j = it & 15, h = (it >> 4) & 3, b = it >> 6;
        const bf16* p = F.PROJ + ((size_t)b * SEQ + j * LBLK + rg * 64) * NPROJ + C_MK + h * HD + d;
        float s = 0.f;
#pragma unroll 8
        for (int r = 0; r < 64; ++r) s += bf2f(p[(size_t)r * NPROJ]);
        red[rg * 128 + d] = s;
        __syncthreads();
        if (F.tid < 128) F.KMEAN[(size_t)it * HD + d] = (red[d] + red[128 + d] + red[256 + d] + red[384 + d]) * (1.f / 256.f);
        __syncthreads();
    }
}
__device__ __forceinline__ void ret_simple_chain(Frame& F, int b, int h) {
    const int tid = F.tid, e = tid & 127, dg = tid >> 7, lane = F.lane;
    LAS float* kl = (LAS float*)F.lds;
    LAS float* ql = kl + 256;
    LAS float* part = ql + 256;
    const float gamma = 1.f - exp2f(-5.f - (float)h);
    float S[32];
#pragma unroll
    for (int i = 0; i < 32; ++i) S[i] = 0.f;
    const bf16* base = F.PROJ + (size_t)b * SEQ * NPROJ + h * HD;
    unsigned nk = 0, nq = 0, nv, ng0 = 0, ng1 = 0;
    if (tid < 128) { nk = base[C_RK + tid]; nq = base[C_RQ + tid]; }
    if (tid < 64) { ng0 = base[C_RG + lane]; ng1 = base[C_RG + lane + 64]; }
    nv = base[C_RV + e];
    for (int t = 0; t < SEQ; ++t) {
        const int pb = t & 1;
        if (tid < 128) { kl[pb * 128 + tid] = bf2f(nk); ql[pb * 128 + tid] = bf2f(nq); }
        const float v = bf2f(nv), g0 = bf2f(ng0), g1 = bf2f(ng1);
        if (t + 1 < SEQ) { const bf16* nb = base + (size_t)(t + 1) * NPROJ;
            if (tid < 128) { nk = nb[C_RK + tid]; nq = nb[C_RQ + tid]; }
            if (tid < 64) { ng0 = nb[C_RG + lane]; ng1 = nb[C_RG + lane + 64]; }
            nv = nb[C_RV + e]; }
        __syncthreads();
        float yp = 0.f;
#pragma unroll
        for (int i = 0; i < 32; i += 4) { const f32x4 k4 = *(LAS f32x4*)(kl + pb * 128 + dg * 32 + i), q4 = *(LAS f32x4*)(ql + pb * 128 + dg * 32 + i);
            S[i] = fmaf(gamma, S[i], k4[0] * v); yp = fmaf(q4[0], S[i], yp);
            S[i + 1] = fmaf(gamma, S[i + 1], k4[1] * v); yp = fmaf(q4[1], S[i + 1], yp);
            S[i + 2] = fmaf(gamma, S[i + 2], k4[2] * v); yp = fmaf(q4[2], S[i + 2], yp);
            S[i + 3] = fmaf(gamma, S[i + 3], k4[3] * v); yp = fmaf(q4[3], S[i + 3], yp); }
        part[(pb * 4 + dg) * 128 + e] = yp;
        __syncthreads();
        if (tid < 64) {
            LAS float* pp = part + pb * 512;
            const float y0 = (pp[lane] + pp[128 + lane]) + (pp[256 + lane] + pp[384 + lane]);
            const float y1 = (pp[lane + 64] + pp[128 + lane + 64]) + (pp[256 + lane + 64] + pp[384 + lane + 64]);
            const float mean = wave_sum(y0 + y1) * (1.f / 128.f); const float d0 = y0 - mean, d1 = y1 - mean;
            const float rstd = 1.f / sqrtf(wave_sum(d0 * d0 + d1 * d1) * (1.f / 128.f) + LN_EPS);
            bf16* yo = F.Y + ((size_t)b * SEQ + t) * DM + h * HD;
            yo[lane] = (bf16)f2bf(silu_f(g0) * d0 * rstd); yo[lane + 64] = (bf16)f2bf(silu_f(g1) * d1 * rstd);
        }
    }
    __syncthreads();
}
__device__ __forceinline__ void moba_simple_wave(Frame& F, int qh, LAS float* wl) {
    const int lane = F.lane;
    const int row = qh >> 2, h = qh & 3, b = row >> 12, t = row & 4095, blk = t >> 8;
    const bf16* P = F.PROJ;
    { const unsigned qq = *(const unsigned*)(P + (size_t)row * NPROJ + C_MQ + h * HD + 2 * lane); wl[2 * lane] = bf2f(qq & 0xffffu); wl[2 * lane + 1] = bf2f(qq >> 16); }
    float gate = -INFINITY;
    if (lane < blk) { const float* km = F.KMEAN + (size_t)((b * NH + h) * NBLK + lane) * HD; float g = 0.f;
        for (int d = 0; d < HD; d += 4) { const f32x4 kv = *(const f32x4*)(km + d); const f32x4 qv = *(LAS f32x4*)(wl + d); g += (kv[0] * qv[0] + kv[1] * qv[1]) + (kv[2] * qv[2] + kv[3] * qv[3]); }
        gate = g; }
    const int nsel = blk < 3 ? blk : 3;
    int s0 = 0, s1 = 0, s2 = 0;
#pragma unroll
    for (int s = 0; s < 3; ++s) {
        float bv = gate; int bi = lane;
#pragma unroll
        for (int o = 1; o < 64; o <<= 1) { const float ov = __shfl_xor(bv, o); const int oi = __shfl_xor(bi, o); if (ov > bv || (ov == bv && oi < bi)) { bv = ov; bi = oi; } }
        if (s == 0) s0 = bi; else if (s == 1) s1 = bi; else s2 = bi;
        if (lane == bi) gate = -INFINITY;
    }
    const float slope2 = exp2f(-2.f * (float)(h + 1)) * LOG2E;
    float sc[4][4]; float mx = -INFINITY;
#pragma unroll
    for (int s = 0; s < 4; ++s) {
        const int bid = (s == 0) ? s0 : (s == 1) ? s1 : (s == 2) ? s2 : blk;
        const bool valid = (s == 3) || (s < nsel);
#pragma unroll
        for (int i = 0; i < 4; ++i) {
            float score = -INFINITY;
            if (valid && (s < 3 || i * 64 <= (t & 255))) {
                const int key = bid * LBLK + i * 64 + lane;
                const bf16* kr = P + ((size_t)b * SEQ + key) * NPROJ + C_MK + h * HD;
                float dot = 0.f;
#pragma unroll 4
                for (int d = 0; d < HD; d += 8) { const v4u kk = *(const v4u*)(kr + d); const f32x4 q0 = *(LAS f32x4*)(wl + d), q1 = *(LAS f32x4*)(wl + d + 4);
                    dot += bf2f(kk[0] & 0xffffu) * q0[0] + bf2f(kk[0] >> 16) * q0[1] + bf2f(kk[1] & 0xffffu) * q0[2] + bf2f(kk[1] >> 16) * q0[3]
                         + bf2f(kk[2] & 0xffffu) * q1[0] + bf2f(kk[2] >> 16) * q1[1] + bf2f(kk[3] & 0xffffu) * q1[2] + bf2f(kk[3] >> 16) * q1[3]; }
                const int dist = t - key;
                if (dist >= 0) score = dot - slope2 * (float)dist;
            }
            sc[s][i] = score; mx = fmaxf(mx, score);
        }
    }
    mx = wave_max(mx);
    float l = 0.f;
#pragma unroll
    for (int s = 0; s < 4; ++s)
#pragma unroll
        for (int i = 0; i < 4; ++i) { sc[s][i] = __builtin_amdgcn_exp2f(sc[s][i] - mx); l += sc[s][i]; }
    l = wave_sum(l);
    float o0 = 0.f, o1 = 0.f;
#pragma unroll
    for (int s = 0; s < 4; ++s) {
        const int bid = (s == 0) ? s0 : (s == 1) ? s1 : (s == 2) ? s2 : blk;
        const bool valid = (s == 3) || (s < nsel);
#pragma unroll
        for (int i = 0; i < 4; ++i) {
            if (valid && (s < 3 || i * 64 <= (t & 255))) {
                wl[128 + lane] = sc[s][i];
                const bf16* vr = P + ((size_t)b * SEQ + bid * LBLK + i * 64) * NPROJ + C_MV + h * HD + 2 * lane;
#pragma unroll 8
                for (int kk = 0; kk < 64; ++kk) { const float p = wl[128 + kk]; const unsigned vv = *(const unsigned*)(vr + (size_t)kk * NPROJ);
                    o0 = fmaf(p, bf2f(vv & 0xffffu), o0); o1 = fmaf(p, bf2f(vv >> 16), o1); }
            }
        }
    }
    const float rl = 1.f / l;
    *(unsigned*)(F.Y + (size_t)row * DM + 512 + h * HD + 2 * lane) = pk2(o0 * rl, o1 * rl);
}
__device__ __forceinline__ void p5_mixers_simple(Frame& F) {
    if (blockIdx.x < BATCH * NH) ret_simple_chain(F, blockIdx.x >> 2, blockIdx.x & 3);
    LAS float* wl = (LAS float*)(F.lds + 8192) + F.wave * 192;
    const int gw = blockIdx.x * NWAVES + F.wave, NGW = F.G * NWAVES;
    for (int qh = gw; qh < M * NH; qh += NGW) moba_simple_wave(F, qh, wl);
}

constexpr int N_PHASES = 11;
#ifndef MK_N_LAUNCHES
#define MK_N_LAUNCHES 11
#endif
constexpr int N_LAUNCHES = MK_N_LAUNCHES;
struct Args { const float* in[12]; float* out; unsigned char* ws; int ph_lo, ph_hi; };
__global__ void __launch_bounds__(NWAVES * 64, 2) fwd_kernel(Args args) {
    extern __shared__ __attribute__((aligned(16))) unsigned char lds[];
    Frame F;
    F.lds = (LAS unsigned char*)lds;
    F.MISC = (volatile LAS unsigned*)(F.lds + MISC_OFF);
    F.tid = threadIdx.x; F.lane = F.tid & 63; F.wave = __builtin_amdgcn_readfirstlane(F.tid >> 6); F.G = gridDim.x;
    unsigned char* ws = args.ws;
    F.ctl = (gu32*)(ws + WS_CTL);
    F.x = args.in[0]; F.c = args.in[1]; F.w_ada = args.in[2]; F.b_ada = args.in[3]; F.w_in = args.in[4]; F.w_out = args.in[5];
    F.ln1_w = args.in[6]; F.ln1_b = args.in[7]; F.w_fi = args.in[8]; F.w_fo = args.in[9]; F.ln2_w = args.in[10]; F.ln2_b = args.in[11];
    F.out = args.out;
    F.MOD = (float*)(ws + WS_MOD); F.KMEAN = (float*)(ws + WS_KMEAN);
    F.WIN = (bf16*)(ws + WS_WIN); F.WOUT = (bf16*)(ws + WS_WOUT); F.WFI = (bf16*)(ws + WS_WFI); F.WFO = (bf16*)(ws + WS_WFO);
    F.H1 = (bf16*)(ws + WS_H1); F.PROJ = (bf16*)(ws + WS_PROJ); F.HID = (bf16*)(ws + WS_HID); F.Y = (bf16*)(ws + WS_Y); F.H2 = (bf16*)(ws + WS_H2);
    for (int u = F.tid; u < (LDS_BYTES - LDSCTL_OFF) / 4; u += NWAVES * 64) ((LAS unsigned*)(F.lds + LDSCTL_OFF))[u] = 0u;
    __syncthreads();
    XcdBarrier bar; bar.bar = (unsigned*)(F.ctl + CW_BAR); bar.x = 0; bar.st = nullptr;
    if (N_LAUNCHES == 1) bar = xcd_barrier_post((unsigned*)(F.ctl + CW_BAR), F.MISC + 8);
#define GRID_BAR() do { if (N_LAUNCHES == 1) xcd_barrier(bar); } while (0)
    const int lo = args.ph_lo, hi = args.ph_hi;
#define IN(k) (lo <= (k) && (k) < hi)
#define BOTH(k) (IN(k) && IN((k) + 1))
    if (IN(0)) { p0_prologue(F); if (BOTH(0)) GRID_BAR(); }
    if (IN(1)) { p1_ln_mod(F); if (BOTH(1)) GRID_BAR(); }
    if (IN(2)) {
        pg8::Gemm g{F.H1, F.WIN, M, NPROJ, DM}; pg8::StaticOrder S; S.init(M, NPROJ, F.G, (int)blockIdx.x);
        pg8::EpiProj E{F.PROJ, NPROJ, RSQD, RSQD * LOG2E};
        pg8::gemm_phase<pg8::EpiProj, pg8::StaticOrder, true, true>(F.lds + RING_OFF, g, S, E);
        if (BOTH(2)) GRID_BAR();
    }
    if (IN(3)) { p3_kmean(F); if (BOTH(3)) GRID_BAR(); }
    if (IN(4)) { if (BOTH(4)) GRID_BAR(); }
    if (IN(5)) { p5_mixers_simple(F); if (BOTH(5)) GRID_BAR(); }
    if (IN(6)) {
        pg8::Gemm g{F.Y, F.WOUT, M, DM, DM}; pg8::StaticOrder S; S.init(M, DM, F.G, (int)blockIdx.x);
        pg8::EpiRes E{F.x, F.out, F.MOD + MOD_G1, NADA, ALPHA};
        pg8::gemm_phase<pg8::EpiRes, pg8::StaticOrder, true, true>(F.lds + RING_OFF, g, S, E);
        if (BOTH(6)) GRID_BAR();
    }
    if (IN(7)) { p7_ln_ln(F); if (BOTH(7)) GRID_BAR(); }
    if (IN(8)) {
        pg8::Gemm g{F.H2, F.WFI, M, NFI, DM}; pg8::StaticOrder S; S.init(M, NFI, F.G, (int)blockIdx.x);
        pg8::EpiSwiGLU E{F.HID, DFF};
        pg8::gemm_phase<pg8::EpiSwiGLU, pg8::StaticOrder, true, true>(F.lds + RING_OFF, g, S, E);
        if (BOTH(8)) GRID_BAR();
    }
    if (IN(9)) {
        pg8::Gemm g{F.HID, F.WFO, M, DM, DFF}; pg8::StaticOrder S; S.init(M, DM, F.G, (int)blockIdx.x);
        pg8::EpiRes E{F.out, F.out, F.MOD + MOD_G2, NADA, ALPHA};
        pg8::gemm_phase<pg8::EpiRes, pg8::StaticOrder, true, true>(F.lds + RING_OFF, g, S, E);
        if (BOTH(9)) GRID_BAR();
    }
    if (IN(10)) { p10_ln_final(F); }
#undef IN
#undef BOTH
}

extern "C" void kernel_launch(void* const* d_in, const int* in_sizes, int n_in, void* d_out, int out_size, void* d_ws, size_t ws_size, hipStream_t stream) {
    static int grid = 0;
    if (grid == 0) {
        if (n_in != 12 || in_sizes[0] != M * DM || out_size != M * DM || ws_size < WS_END) {
            fprintf(stderr, "kernel_launch: shape mismatch (n_in %d, in0 %d, out %d, ws %zu; need ws >= %zu); nothing launched\n", n_in, n_in > 0 ? in_sizes[0] : -1, out_size, ws_size, (size_t)WS_END); grid = -1; return; }
        int dev = 0, cus = 0, per_cu = 0;
        if (hipGetDevice(&dev) != hipSuccess || hipDeviceGetAttribute(&cus, hipDeviceAttributeMultiprocessorCount, dev) != hipSuccess) { fprintf(stderr, "kernel_launch: device query failed\n"); grid = -1; return; }
        if (hipFuncSetAttribute((const void*)fwd_kernel, hipFuncAttributeMaxDynamicSharedMemorySize, LDS_BYTES) != hipSuccess) { fprintf(stderr, "kernel_launch: hipFuncSetAttribute failed\n"); grid = -1; return; }
        if (hipOccupancyMaxActiveBlocksPerMultiprocessor(&per_cu, (const void*)fwd_kernel, NWAVES * 64, LDS_BYTES) != hipSuccess || per_cu < 1)
            fprintf(stderr, "kernel_launch: note: occupancy query reports %d workgroups per CU\n", per_cu);
        (void)hipGetLastError();
        grid = cus;
        if (grid != 256) fprintf(stderr, "kernel_launch: note: %d CUs (built for 256)\n", grid);
    }
    if (grid < 0) return;
    if (hipMemsetAsync((char*)d_ws + WS_CTL, 0, CTL_ZERO_BYTES, stream) != hipSuccess) { fprintf(stderr, "kernel_launch: memset failed\n"); return; }
    Args a{};
    for (int i = 0; i < 12; ++i) a.in[i] = (const float*)d_in[i];
    a.out = (float*)d_out; a.ws = (unsigned char*)d_ws;
    for (int li = 0; li < N_LAUNCHES; ++li) {
        a.ph_lo = (N_LAUNCHES == 1) ? 0 : li; a.ph_hi = (N_LAUNCHES == 1) ? N_PHASES : li + 1;
        hipLaunchKernelGGL(fwd_kernel, dim3(grid), dim3(NWAVES * 64), LDS_BYTES, stream, a);
        const hipError_t le = hipPeekAtLastError();
        if (le != hipSuccess) { fprintf(stderr, "kernel_launch: launch %d failed: %s\n", li, hipGetErrorName(le)); break; }
    }
}
```

```cpp
#include <hip/hip_runtime.h>
#include <cstdio>
#include <cstdint>
#include <cmath>
namespace pg8 {
#define PG8_LAS __attribute__((address_space(3)))
typedef unsigned short bf16_t;
typedef short bf16x8 __attribute__((ext_vector_type(8)));
typedef float f32x4 __attribute__((ext_vector_type(4)));
typedef unsigned u32x4 __attribute__((ext_vector_type(4)));
constexpr int BM = 256, BK = 64, HALF = 128, HTB = HALF * BK * 2  , STAGE_BYTES = 8 * HTB, NXCD = 8, WGM = 8;

__host__ __device__ __forceinline__ int lds_byte(int r, int c) { const int st = (r >> 4) * 2 + (c >> 5), rr = r & 15, cc = c & 31, ob = rr * 64 + cc * 2; return st * 1024 + (ob ^ (((ob >> 9) & 1) << 5)); }
__host__ __device__ __forceinline__ void stage_rc(int b, int& R, int& C) { const int st = b / 1024, sb = b % 1024, swz = sb ^ (((sb >> 9) & 1) << 5); R = (st >> 1) * 16 + swz / 64; C = (st & 1) * 32 + (swz % 64) / 2; }
__host__ __device__ __forceinline__ int perm32(int rho) { const int n = rho >> 4, i = rho & 15; return 8 * (i >> 2) + 4 * n + (i & 3); }

struct Unit { int pm, pn; };
struct Gemm { const bf16_t* A; const bf16_t* Bt; int M, N, K; };

struct StaticOrder {
    int nM, nN, nwg, G, c;
    __host__ __device__ void init(int M, int N, int G_, int c_) { nM = M / BM; nN = N / BM; nwg = nM * nN; G = G_; c = c_; }
    __host__ __device__ bool next(int i, Unit& u) const {
        const long L = (long)i * G + c; if (L >= nwg) return false;
        int wgid = (int)L; { const int q = nwg / NXCD, r = nwg % NXCD, xcd = wgid % NXCD, off = wgid / NXCD; wgid = (xcd < r ? xcd * (q + 1) : r * (q + 1) + (xcd - r) * q) + off; }
        const int nig = WGM * nN, gid = wgid / nig, fm = gid * WGM, gsz = (nM - fm) < WGM ? (nM - fm) : WGM;
        u.pm = fm + ((wgid % nig) % gsz); u.pn = (wgid % nig) / gsz; return true;
    }
    __device__ __forceinline__ void a_ready(const Unit&) const {}
    __device__ __forceinline__ void done(const Unit&) const {}
};

__device__ __forceinline__ unsigned cvt_pk_bf16(float lo, float hi) { unsigned r; asm volatile("v_cvt_pk_bf16_f32 %0, %1, %2" : "=v"(r) : "v"(lo), "v"(hi)); return r; }
typedef float f32x2 __attribute__((ext_vector_type(2)));
struct EpiProj {
    static constexpr bool PERM = true, AFTER_DRAIN = false;
    bf16_t* O; int ldc; float s_rk, s_mq;
    __device__ __forceinline__ void operator()(const f32x4 (&acc)[2][2][4][2], const Unit& u, int wr, int wc, int fr, int fq) const {
        const int row0 = u.pm * BM + wr * 64 + fr, col0 = u.pn * BM + wc * 32 + 8 * fq;
        const float sc = (u.pn == 2 || u.pn == 3) ? s_rk : ((u.pn == 8 || u.pn == 9) ? s_mq : 1.0f);
#pragma unroll
        for (int ai = 0; ai < 2; ++ai)
#pragma unroll
            for (int m = 0; m < 4; ++m) { bf16_t* rowp = O + (size_t)(row0 + ai * HALF + m * 16) * ldc + col0;
#pragma unroll
                for (int bj = 0; bj < 2; ++bj) { const f32x4 v0 = acc[ai][bj][m][0] * sc, v1 = acc[ai][bj][m][1] * sc;
                    u32x4 w; w.x = cvt_pk_bf16(v0[0], v0[1]); w.y = cvt_pk_bf16(v0[2], v0[3]); w.z = cvt_pk_bf16(v1[0], v1[1]); w.w = cvt_pk_bf16(v1[2], v1[3]);
                    *(u32x4*)(rowp + bj * HALF) = w; } }
    }
};
struct EpiRes {
    static constexpr bool PERM = false, AFTER_DRAIN = false;
    const float* base; float* out; const float* gate; int gate_stride; float alpha;
    __device__ __forceinline__ void operator()(const f32x4 (&acc)[2][2][4][2], const Unit& u, int wr, int wc, int fr, int fq) const {
        const int row0 = u.pm * BM + wr * 64 + fr, col0 = u.pn * BM + wc * 32 + 4 * fq;
        const float* g = gate + (size_t)(u.pm >> 4) * gate_stride + col0;
        f32x4 gv[2][2];
#pragma unroll
        for (int bj = 0; bj < 2; ++bj)
#pragma unroll
            for (int n = 0; n < 2; ++n) gv[bj][n] = *(const f32x4*)(g + bj * HALF + n * 16);
#pragma unroll
        for (int ai = 0; ai < 2; ++ai)
#pragma unroll
            for (int m = 0; m < 4; ++m) { const size_t off = (size_t)(row0 + ai * HALF + m * 16) * 1024 + col0;
#pragma unroll
                for (int bj = 0; bj < 2; ++bj)
#pragma unroll
                    for (int n = 0; n < 2; ++n) { const f32x4 bs = *(const f32x4*)(base + off + bj * HALF + n * 16);
                        *(f32x4*)(out + off + bj * HALF + n * 16) = bs * alpha + gv[bj][n] * acc[ai][bj][m][n]; }
                if (m & 1) asm volatile("" ::: "memory"); }
    }
};
struct EpiSwiGLU {
    static constexpr bool PERM = true, AFTER_DRAIN = false;
    bf16_t* O; int ldc;
    __device__ __forceinline__ void operator()(const f32x4 (&acc)[2][2][4][2], const Unit& u, int wr, int wc, int fr, int fq) const {
        const int row0 = u.pm * BM + wr * 64 + fr, col0 = u.pn * HALF + wc * 32 + 8 * fq;
#pragma unroll
        for (int ai = 0; ai < 2; ++ai)
#pragma unroll
            for (int m = 0; m < 4; ++m) { bf16_t* rowp = O + (size_t)(row0 + ai * HALF + m * 16) * ldc + col0;
                float h[8];
#pragma unroll
                for (int n = 0; n < 2; ++n)
#pragma unroll
                    for (int i = 0; i < 4; ++i) { const float gt = acc[ai][0][m][n][i], up = acc[ai][1][m][n][i];
                        h[n * 4 + i] = gt * __builtin_amdgcn_rcpf(1.0f + __builtin_amdgcn_exp2f(-1.4426950408889634f * gt)) * up; }
                u32x4 w; w.x = cvt_pk_bf16(h[0], h[1]); w.y = cvt_pk_bf16(h[2], h[3]); w.z = cvt_pk_bf16(h[4], h[5]); w.w = cvt_pk_bf16(h[6], h[7]);
                *(u32x4*)rowp = w; }
    }
};
template <class Epi, class Sched, bool ALIGN_EPI = false, bool SP2 = false>
__device__ __forceinline__ void gemm_phase(PG8_LAS unsigned char* lds, const Gemm g, const Sched& S, const Epi& E) {
    const int tid = threadIdx.x, wid = __builtin_amdgcn_readfirstlane(tid >> 6), lane = tid & 63, wr = wid >> 2, wc = wid & 3, fr = lane & 15, fq = lane >> 4;
    const int K = g.K, nt = K / BK;
    unsigned voffA[2], voffB[2];
#pragma unroll
    for (int i = 0; i < 2; ++i) { int R, C; stage_rc(tid * 16 + i * 8192, R, C); const int Rb = Epi::PERM ? ((R & ~31) + perm32(R & 31)) : R;
        voffA[i] = (unsigned)(R * K + C) * 2u; voffB[i] = (unsigned)(Rb * K + C) * 2u; }
    const size_t kstep = (size_t)(BK * 2);
    const size_t hstep = (size_t)HALF * K * 2;
    const size_t tstep = 2 * hstep;
    const unsigned ldsw = (unsigned)wid * 1024u;
    const int aoff = lds_byte(wr * 64 + fr, fq * 8), boff = lds_byte(wc * 32 + fr, fq * 8);
#define PG8_SA(b, h) (((b) * 2 + (h)) * HTB)
#define PG8_SB(b, h) ((4 + (b) * 2 + (h)) * HTB)
#define PG8_STAGE(bufoff, gbase, voff) do { _Pragma("unroll") for (int _i = 0; _i < 2; ++_i) \
        __builtin_amdgcn_global_load_lds((const unsigned*)((const char*)(gbase) + (voff)[_i]), (PG8_LAS unsigned*)(lds + (bufoff) + ldsw + _i * 8192), 16, 0, 0); } while (0)
#define PG8_LDA(dst, b, h) do { _Pragma("unroll") for (int m = 0; m < 4; ++m) _Pragma("unroll") for (int k = 0; k < 2; ++k) dst[m][k] = *(const PG8_LAS bf16x8*)(lds + PG8_SA(b, h) + aoff + m * 2048 + k * 1024); } while (0)
#define PG8_LDB(dst, b, h) do { _Pragma("unroll") for (int n = 0; n < 2; ++n) _Pragma("unroll") for (int k = 0; k < 2; ++k) dst[n][k] = *(const PG8_LAS bf16x8*)(lds + PG8_SB(b, h) + boff + n * 2048 + k * 1024); } while (0)
#define PG8_MMA(ai, bj, At, Bt) do { __builtin_amdgcn_s_setprio(1); _Pragma("unroll") for (int m = 0; m < 4; ++m) _Pragma("unroll") for (int n = 0; n < 2; ++n) _Pragma("unroll") for (int k = 0; k < 2; ++k) \
        acc[ai][bj][m][n] = __builtin_amdgcn_mfma_f32_16x16x32_bf16(Bt[n][k], At[m][k], acc[ai][bj][m][n], 0, 0, 0); __builtin_amdgcn_s_setprio(0); } while (0)
#define PG8_WAIT_V(n) asm volatile("s_waitcnt vmcnt(" #n ")" ::: "memory")
#define PG8_WAIT_L(n) asm volatile("s_waitcnt lgkmcnt(" #n ")" ::: "memory")
#define PG8_BAR __builtin_amdgcn_s_barrier()
#define PG8_SCHED __builtin_amdgcn_sched_barrier(0)
    Unit cur, nxt; int ui = 0;
    if (!S.next(0, cur)) return;
    f32x4 acc[2][2][4][2];
#pragma unroll
    for (int a = 0; a < 2; ++a)
#pragma unroll
        for (int b = 0; b < 2; ++b)
#pragma unroll
            for (int m = 0; m < 4; ++m)
#pragma unroll
                for (int n = 0; n < 2; ++n) acc[a][b][m][n] = (f32x4){0.f, 0.f, 0.f, 0.f};
    bf16x8 At[4][2], B0[2][2], B1[2][2];
    const char* cA = (const char*)g.A + (size_t)cur.pm * tstep; const char* cB = (const char*)g.Bt + (size_t)cur.pn * tstep;
    S.a_ready(cur);
    if constexpr (SP2) {
        PG8_STAGE(PG8_SB(0, 0), cB, voffB); PG8_STAGE(PG8_SB(0, 1), cB + hstep, voffB); PG8_STAGE(PG8_SA(0, 0), cA, voffA); PG8_STAGE(PG8_SA(0, 1), cA + hstep, voffA);
        if (wr == 1) PG8_BAR;
        PG8_WAIT_V(2); PG8_BAR;
        PG8_STAGE(PG8_SB(1, 0), cB + kstep, voffB); PG8_STAGE(PG8_SA(1, 0), cA + kstep, voffA); PG8_STAGE(PG8_SB(1, 1), cB + hstep + kstep, voffB);
        PG8_WAIT_V(6); PG8_BAR;
    } else {
        PG8_STAGE(PG8_SB(0, 0), cB, voffB); PG8_STAGE(PG8_SA(0, 0), cA, voffA); PG8_STAGE(PG8_SB(0, 1), cB + hstep, voffB); PG8_STAGE(PG8_SA(0, 1), cA + hstep, voffA);
        if (wr == 1) PG8_BAR;
        PG8_WAIT_V(4); PG8_BAR;
        PG8_STAGE(PG8_SB(1, 0), cB + kstep, voffB); PG8_STAGE(PG8_SA(1, 0), cA + kstep, voffA); PG8_STAGE(PG8_SB(1, 1), cB + hstep + kstep, voffB);
        PG8_WAIT_V(6); PG8_BAR;
    }
    for (;;) {
        const bool has_next = S.next(ui + 1, nxt);
        const char* nA = has_next ? (const char*)g.A + (size_t)nxt.pm * tstep : cA; const char* nB = has_next ? (const char*)g.Bt + (size_t)nxt.pn * tstep : cB;
        for (int t = 0; t < nt; t += 2) {
            const bool last = (t == nt - 2);
            const char* a1 = cA + (size_t)(t + 1) * kstep;
            const char* a2 = last ? nA : cA + (size_t)(t + 2) * kstep; const char* b2 = last ? nB : cB + (size_t)(t + 2) * kstep;
            const char* a3 = a2 + kstep; const char* b3 = b2 + kstep;
            if (last && has_next) S.a_ready(nxt);
            if constexpr (SP2) {
            PG8_LDB(B0, 0, 0); PG8_LDB(B1, 0, 1); PG8_SCHED; PG8_LDA(At, 0, 0); PG8_STAGE(PG8_SA(1, 1), a1 + hstep, voffA);
            PG8_WAIT_V(8); PG8_WAIT_L(0); PG8_BAR; PG8_MMA(0, 0, At, B0); PG8_MMA(0, 1, At, B1); PG8_BAR; PG8_SCHED;
            PG8_LDA(At, 0, 1); PG8_STAGE(PG8_SB(0, 0), b2, voffB); PG8_STAGE(PG8_SB(0, 1), b2 + hstep, voffB); PG8_STAGE(PG8_SA(0, 0), a2, voffA);
            PG8_WAIT_V(8); PG8_WAIT_L(0); PG8_BAR; PG8_MMA(1, 0, At, B0); PG8_MMA(1, 1, At, B1); PG8_BAR; PG8_SCHED;
            PG8_LDB(B0, 1, 0); PG8_LDB(B1, 1, 1); PG8_SCHED; PG8_LDA(At, 1, 0); PG8_STAGE(PG8_SA(0, 1), a2 + hstep, voffA);
            PG8_WAIT_V(8); PG8_WAIT_L(0); PG8_BAR; PG8_MMA(0, 0, At, B0); PG8_MMA(0, 1, At, B1); PG8_BAR; PG8_SCHED;
            PG8_LDA(At, 1, 1); PG8_STAGE(PG8_SB(1, 0), b3, voffB); PG8_STAGE(PG8_SB(1, 1), b3 + hstep, voffB); PG8_STAGE(PG8_SA(1, 0), a3, voffA);
            PG8_WAIT_V(8); PG8_WAIT_L(0); PG8_BAR; PG8_MMA(1, 0, At, B0); PG8_MMA(1, 1, At, B1); PG8_BAR; PG8_SCHED;
            } else {
            PG8_LDB(B0, 0, 0); PG8_SCHED; PG8_LDA(At, 0, 0); PG8_STAGE(PG8_SA(1, 1), a1 + hstep, voffA);
            PG8_WAIT_L(8); PG8_BAR; PG8_WAIT_L(0); PG8_MMA(0, 0, At, B0); PG8_BAR; PG8_SCHED;
            PG8_LDB(B1, 0, 1); PG8_STAGE(PG8_SB(0, 0), b2, voffB);
            PG8_BAR; PG8_WAIT_L(0); PG8_MMA(0, 1, At, B1); PG8_BAR;
            PG8_LDA(At, 0, 1); PG8_STAGE(PG8_SA(0, 0), a2, voffA);
            PG8_BAR; PG8_WAIT_L(0); PG8_MMA(1, 0, At, B0); PG8_BAR; PG8_SCHED;
            PG8_STAGE(PG8_SB(0, 1), b2 + hstep, voffB);
            PG8_WAIT_V(6); PG8_BAR; PG8_MMA(1, 1, At, B1); PG8_BAR;
            PG8_LDB(B0, 1, 0); PG8_SCHED; PG8_LDA(At, 1, 0); PG8_STAGE(PG8_SA(0, 1), a2 + hstep, voffA);
            PG8_WAIT_L(8); PG8_BAR; PG8_WAIT_L(0); PG8_MMA(0, 0, At, B0); PG8_BAR; PG8_SCHED;
            PG8_LDB(B1, 1, 1); PG8_STAGE(PG8_SB(1, 0), b3, voffB);
            PG8_BAR; PG8_WAIT_L(0); PG8_MMA(0, 1, At, B1); PG8_BAR;
            PG8_LDA(At, 1, 1); PG8_STAGE(PG8_SA(1, 0), a3, voffA);
            PG8_BAR; PG8_WAIT_L(0); PG8_MMA(1, 0, At, B0); PG8_BAR; PG8_SCHED;
            PG8_STAGE(PG8_SB(1, 1), b3 + hstep, voffB);
            PG8_WAIT_V(6); PG8_BAR; PG8_MMA(1, 1, At, B1); PG8_BAR;
            }
        }
        if constexpr (ALIGN_EPI) { if (wr == 0) PG8_BAR; }
        if constexpr (!Epi::AFTER_DRAIN) { E(acc, cur, wr, wc, fr, fq); S.done(cur); }
        if (!has_next) break;
#pragma unroll
        for (int a = 0; a < 2; ++a)
#pragma unroll
            for (int b = 0; b < 2; ++b)
#pragma unroll
                for (int m = 0; m < 4; ++m)
#pragma unroll
                    for (int n = 0; n < 2; ++n) acc[a][b][m][n] = (f32x4){0.f, 0.f, 0.f, 0.f};
        cur = nxt; cA = nA; cB = nB; ++ui;
        if constexpr (ALIGN_EPI) { if (wr == 1) PG8_BAR; }
    }
    PG8_WAIT_V(0);
    if constexpr (!ALIGN_EPI) { if (wr == 0) PG8_BAR; }
    PG8_BAR;
    if constexpr (Epi::AFTER_DRAIN) { E.fused(acc, cur, wr, wc, fr, fq, lds, wid, lane); S.done(cur); }
#undef PG8_SA
#undef PG8_SB
#undef PG8_STAGE
#undef PG8_LDA
#undef PG8_LDB
#undef PG8_MMA
#undef PG8_WAIT_V
#undef PG8_WAIT_L
#undef PG8_BAR
#undef PG8_SCHED
}
}
#define GAS __attribute__((address_space(1)))
#define LAS __attribute__((address_space(3)))
typedef unsigned short bf16;
typedef unsigned v4u __attribute__((ext_vector_type(4)));
typedef float f32x4 __attribute__((ext_vector_type(4)));
typedef short bf16x8 __attribute__((ext_vector_type(8)));
typedef GAS unsigned gu32;
typedef GAS unsigned long long gu64;
#define RLX_AGENT __ATOMIC_RELAXED, __HIP_MEMORY_SCOPE_AGENT
#define LDS_WAIT() asm volatile("s_waitcnt lgkmcnt(0)" ::: "memory")
#define VM_WAIT() asm volatile("s_waitcnt vmcnt(0)" ::: "memory")
__device__ __forceinline__ unsigned long long rt() { return __builtin_amdgcn_s_memrealtime(); }
__device__ __forceinline__ unsigned f2bf(float f) { unsigned u = __builtin_bit_cast(unsigned, f); return (u + 0x7fffu + ((u >> 16) & 1u)) >> 16; }
__device__ __forceinline__ unsigned pk2(float lo, float hi) { return f2bf(lo) | (f2bf(hi) << 16); }
#define XB_TMO      128
#define XB_XCNT(j)  (256  + 64 * (j))
#define XB_XSUB(j)  (1280 + 64 * (j))
#define XB_XGEN(j)  (2304 + 64 * (j))
#define XB_TOP      3328
#define XB_TOPGEN   3392
#define XCD_BAR_WORDS 3456
#define XB_SPIN_CAP (1u << 18)

__device__ __forceinline__ unsigned xb_ld(unsigned* p)              { return __hip_atomic_load(p, __ATOMIC_RELAXED, __HIP_MEMORY_SCOPE_AGENT); }
__device__ __forceinline__ unsigned xb_add(unsigned* p, unsigned v) { return __hip_atomic_fetch_add(p, v, __ATOMIC_RELAXED, __HIP_MEMORY_SCOPE_AGENT); }
__device__ __forceinline__ unsigned xb_xcc_id() { return (unsigned)__builtin_amdgcn_s_getreg((3 << 11) | 20) & 0xFu; }
#define XB_SPIN(cond, bar) do { unsigned _sp = 0; while (cond) { __builtin_amdgcn_s_sleep(1); \
    if ((++_sp & 255u) == 0u) { if (xb_ld(&(bar)[XB_TMO])) break; if (_sp > XB_SPIN_CAP) { atomicAdd(&(bar)[XB_TMO], 1u); break; } } } } while (0)

struct XcdBarrier {
    unsigned* bar; unsigned x;
    volatile LAS unsigned* st;
};

__device__ __forceinline__ XcdBarrier xcd_barrier_post(unsigned* bar, volatile LAS unsigned* st) {
    XcdBarrier b; b.bar = bar; b.x = xb_xcc_id(); b.st = st;
    if (threadIdx.x == 0) (void)xb_add(&bar[XB_XCNT(b.x)], 1u);
    return b;
}
__device__ __forceinline__ void xcd_barrier_complete(unsigned* bar, unsigned x, unsigned& nloc, unsigned& nx) {
    const unsigned G = gridDim.x * gridDim.y * gridDim.z;
    unsigned sum, cnt, mine, sp = 0u;
    for (;;) {
        sum = 0u; cnt = 0u; mine = 0u;
#pragma unroll
        for (unsigned j = 0; j < 16; ++j) { const unsigned c = xb_ld(&bar[XB_XCNT(j)]); sum += c; cnt += (c > 0u) ? 1u : 0u; mine = (j == x) ? c : mine; }
        if (sum == G) break;
        __builtin_amdgcn_s_sleep(1);
        if ((++sp & 255u) == 0u) { if (xb_ld(&bar[XB_TMO])) break; if (sp > XB_SPIN_CAP) { atomicAdd(&bar[XB_TMO], 1u); break; } }
    }
    nloc = mine > 0u ? mine : 1u; nx = cnt > 0u ? cnt : 1u;
}

__device__ __forceinline__ void xcd_barrier(const XcdBarrier& b) {
    asm volatile("s_waitcnt vmcnt(0)" ::: "memory");
    __syncthreads();
    if (threadIdx.x == 0) {
        unsigned* bar = b.bar;
        __builtin_amdgcn_s_waitcnt(0);
        unsigned nloc = b.st[0], nx = b.st[1];
        if (nloc == 0u) { xcd_barrier_complete(bar, b.x, nloc, nx); b.st[0] = nloc; b.st[1] = nx; }
        const unsigned old = xb_add(&bar[XB_XSUB(b.x)], 1u);
        const unsigned gen = old / nloc;
        if (old + 1u == (gen + 1u) * nloc) {
            __builtin_amdgcn_fence(__ATOMIC_RELEASE, "agent");
            asm volatile("s_waitcnt vmcnt(0)" ::: "memory");
            const unsigned og = xb_add(&bar[XB_TOP], 1u);
            const unsigned tg = og / nx;
            if (og + 1u == (tg + 1u) * nx) xb_add(&bar[XB_TOPGEN], 1u);
            else XB_SPIN(xb_ld(&bar[XB_TOPGEN]) == tg, bar);
            __builtin_amdgcn_fence(__ATOMIC_ACQUIRE, "agent");
            xb_add(&bar[XB_XGEN(b.x)], 1u);
            asm volatile("s_waitcnt vmcnt(0)" ::: "memory");
        } else {
            XB_SPIN(xb_ld(&bar[XB_XGEN(b.x)]) == gen, bar);
            __builtin_amdgcn_fence(__ATOMIC_ACQUIRE, "agent");
            asm volatile("s_waitcnt vmcnt(0)" ::: "memory");
        }
    }
    __syncthreads();
}
__device__ __forceinline__ float wave_sum(float v) {
#pragma unroll
    for (int o = 1; o < 64; o <<= 1) v += __shfl_xor(v, o);
    return v;
}
__device__ __forceinline__ void p0_transpose_item(const float* W, int K, int N, bf16* WT, int row_off, LAS float* scr, int item, int lane) {
    const int nblk = N / 32, kb = item / nblk, nb = item % nblk, k0 = 64 * kb, n0 = 32 * nb;
#pragma unroll 8
    for (int i = 0; i < 32; ++i) { const int kk = 2 * i + (lane >> 5); scr[kk * 33 + (lane & 31)] = W[(size_t)(k0 + kk) * N + n0 + (lane & 31)]; }
    LDS_WAIT(); asm volatile("" ::: "memory");
    const int c = lane & 7;
#pragma unroll
    for (int j = 0; j < 4; ++j) { const int n = (lane >> 3) + 8 * j; const LAS float* s = scr + (8 * c) * 33 + n;
        v4u o; o.x = pk2(s[0 * 33], s[1 * 33]); o.y = pk2(s[2 * 33], s[3 * 33]); o.z = pk2(s[4 * 33], s[5 * 33]); o.w = pk2(s[6 * 33], s[7 * 33]);
        *(GAS v4u*)(WT + (size_t)(row_off + n0 + n) * K + k0 + 8 * c) = o; }
    LDS_WAIT(); asm volatile("" ::: "memory");
}

constexpr int NWAVES = 8;
constexpr int BATCH = 8, SEQ = 4096, DM = 1024, M = BATCH * SEQ;
constexpr int NPROJ = 3584, DFF = 2816, NFI = 2 * DFF, NADA = 6 * DM;
constexpr int C_RQ = 0, C_RK = 512, C_RV = 1024, C_RG = 1536, C_MQ = 2048, C_MK = 2560, C_MV = 3072;
constexpr int NH = 4, HD = 128, NBLK = 16, LBLK = 256;
constexpr float LN_EPS = 1e-5f;
constexpr float ALPHA = 1.189207115002721f;
constexpr float RSQD = 0.08838834764831845f;
constexpr float LOG2E = 1.4426950408889634f;
constexpr int MOD_SH1 = 0, MOD_SC1 = 1024, MOD_G1 = 2048, MOD_SH2 = 3072, MOD_SC2 = 4096, MOD_G2 = 5120;

constexpr size_t MiB = 1u << 20;
constexpr size_t WS_CTL = 0, CTL_ZERO_BYTES = 1 * MiB;
constexpr size_t WS_MOD = 1 * MiB;
constexpr size_t WS_KMEAN = 1 * MiB + 256 * 1024;
constexpr size_t WS_WIN = 2 * MiB, WS_WOUT = 9 * MiB, WS_WFI = 11 * MiB, WS_WFO = 22 * MiB;
constexpr size_t WS_H1 = 32 * MiB;
constexpr size_t WS_PROJ = 96 * MiB;
constexpr size_t WS_HID = 96 * MiB;
constexpr size_t WS_Y = 320 * MiB;
constexpr size_t WS_H2 = 384 * MiB;
constexpr size_t WS_END = 448 * MiB;
constexpr int CW_TMO = 0, CW_CODE = 1, CW_BAR = 4096;

constexpr int RING_OFF = 0, RING_BYTES = 131072;
constexpr int LDSCTL_OFF = RING_BYTES, MISC_OFF = LDSCTL_OFF + 320;
constexpr int LDS_BYTES = 147456;

struct Frame {
    LAS unsigned char* lds;
    volatile LAS unsigned* MISC;
    gu32* ctl;
    int tid, lane, wave, G;
    const float *x, *c, *w_ada, *b_ada, *w_in, *w_out, *ln1_w, *ln1_b, *w_fi, *w_fo, *ln2_w, *ln2_b;
    float* out;
    float *MOD, *KMEAN;
    bf16 *WIN, *WOUT, *WFI, *WFO, *H1, *PROJ, *HID, *Y, *H2;
};

__device__ __forceinline__ float bf2f(unsigned u16) { return __uint_as_float(u16 << 16); }
__device__ __forceinline__ float wave_max(float v) {
#pragma unroll
    for (int o = 1; o < 64; o <<= 1) v = fmaxf(v, __shfl_xor(v, o));
    return v;
}
__device__ __forceinline__ float silu_f(float v) { return v * __builtin_amdgcn_rcpf(1.0f + __builtin_amdgcn_exp2f(-LOG2E * v)); }

__device__ __forceinline__ void p0_mod_item(Frame& F, int item) {
    LAS float* sl = (LAS float*)(F.lds);
    LAS float* red = (LAS float*)(F.lds + 32768);
    for (int i = F.tid; i < BATCH * DM; i += NWAVES * 64) { const int b = i >> 10, k = i & 1023; sl[k * 8 + b] = silu_f(F.c[i]); }
    __syncthreads();
    const int col = F.tid & 31, kg = F.tid >> 5, n = item * 32 + col;
    float a0 = 0.f, a1 = 0.f, a2 = 0.f, a3 = 0.f, a4 = 0.f, a5 = 0.f, a6 = 0.f, a7 = 0.f;
#pragma unroll 4
    for (int kk = 0; kk < 64; ++kk) { const int k = kg * 64 + kk; const float w = F.w_ada[(size_t)k * NADA + n];
        const f32x4 s0 = *(LAS f32x4*)(sl + k * 8), s1 = *(LAS f32x4*)(sl + k * 8 + 4);
        a0 += s0[0] * w; a1 += s0[1] * w; a2 += s0[2] * w; a3 += s0[3] * w; a4 += s1[0] * w; a5 += s1[1] * w; a6 += s1[2] * w; a7 += s1[3] * w; }
    red[(kg * 8 + 0) * 32 + col] = a0; red[(kg * 8 + 1) * 32 + col] = a1; red[(kg * 8 + 2) * 32 + col] = a2; red[(kg * 8 + 3) * 32 + col] = a3;
    red[(kg * 8 + 4) * 32 + col] = a4; red[(kg * 8 + 5) * 32 + col] = a5; red[(kg * 8 + 6) * 32 + col] = a6; red[(kg * 8 + 7) * 32 + col] = a7;
    __syncthreads();
    if (F.tid < 256) { const int b = F.tid >> 5, cc = F.tid & 31; float s = 0.f;
#pragma unroll
        for (int g = 0; g < 16; ++g) s += red[(g * 8 + b) * 32 + cc];
        F.MOD[b * NADA + item * 32 + cc] = s + F.b_ada[item * 32 + cc]; }
    __syncthreads();
}
__device__ __forceinline__ void p0_prologue(Frame& F) {
    for (int it = blockIdx.x; it < NADA / 32; it += F.G) p0_mod_item(F, it);
    LAS float* scr = (LAS float*)(F.lds + RING_OFF + F.wave * 16384);
    const int gw = blockIdx.x * NWAVES + F.wave, NGW = F.G * NWAVES;
    constexpr int I_IN = (DM / 64) * (NPROJ / 32), I_OUT = (DM / 64) * (DM / 32), I_FI = (DM / 64) * (NFI / 32), I_FO = (DFF / 64) * (DM / 32);
    constexpr int NITEMS = I_IN + I_OUT + I_FI + I_FO;
    for (int it = gw; it < NITEMS; it += NGW) {
        int r = it;
        if (r < I_IN) { p0_transpose_item(F.w_in, DM, NPROJ, F.WIN, 0, scr, r, F.lane); continue; } r -= I_IN;
        if (r < I_OUT) { p0_transpose_item(F.w_out, DM, DM, F.WOUT, 0, scr, r, F.lane); continue; } r -= I_OUT;
        if (r < I_FI) {
            const int nb = r % (NFI / 32), n0 = 32 * nb; const int isup = n0 >= DFF ? 1 : 0, j0 = n0 - isup * DFF;
            const int dst0 = 256 * (j0 >> 7) + 128 * isup + (j0 & 127);
            p0_transpose_item(F.w_fi, DM, NFI, F.WFI, dst0 - n0, scr, r, F.lane); continue; } r -= I_FI;
        p0_transpose_item(F.w_fo, DFF, DM, F.WFO, 0, scr, r, F.lane);
    }
}
__device__ __forceinline__ void row_stats(const f32x4 (&v)[4], float& mean, float& rstd) {
    float s = 0.f;
#pragma unroll
    for (int j = 0; j < 4; ++j) s += (v[j][0] + v[j][1]) + (v[j][2] + v[j][3]);
    mean = wave_sum(s) * (1.f / DM); float s2 = 0.f;
#pragma unroll
    for (int j = 0; j < 4; ++j) { const f32x4 d = v[j] - mean; s2 += (d[0] * d[0] + d[1] * d[1]) + (d[2] * d[2] + d[3] * d[3]); }
    rstd = 1.f / sqrtf(wave_sum(s2) * (1.f / DM) + LN_EPS);
}
__device__ __forceinline__ void p1_ln_mod(Frame& F) {
    const int gw = blockIdx.x * NWAVES + F.wave, NGW = F.G * NWAVES;
    for (int m = gw; m < M; m += NGW) {
        const float* mod = F.MOD + (size_t)(m >> 12) * NADA;
        const GAS f32x4* xr = (const GAS f32x4*)(F.x + (size_t)m * DM) + F.lane;
        f32x4 v[4];
#pragma unroll
        for (int j = 0; j < 4; ++j) v[j] = xr[64 * j];
        float mean, rstd; row_stats(v, mean, rstd);
        GAS unsigned long long* o8 = (GAS unsigned long long*)(F.H1 + (size_t)m * DM) + F.lane;
#pragma unroll
        for (int j = 0; j < 4; ++j) { const int col = 256 * j + 4 * F.lane;
            const f32x4 sc = *(const f32x4*)(mod + MOD_SC1 + col), sh = *(const f32x4*)(mod + MOD_SH1 + col);
            const f32x4 h = (v[j] - mean) * rstd * (sc + 1.0f) + sh;
            o8[64 * j] = (unsigned long long)pk2(h[0], h[1]) | ((unsigned long long)pk2(h[2], h[3]) << 32); }
    }
}
__device__ __forceinline__ void p7_ln_ln(Frame& F) {
    const int gw = blockIdx.x * NWAVES + F.wave, NGW = F.G * NWAVES;
    for (int m = gw; m < M; m += NGW) {
        const float* mod = F.MOD + (size_t)(m >> 12) * NADA;
        GAS f32x4* zr = (GAS f32x4*)(F.out + (size_t)m * DM) + F.lane;
        f32x4 v[4];
#pragma unroll
        for (int j = 0; j < 4; ++j) v[j] = zr[64 * j];
        float mean, rstd; row_stats(v, mean, rstd);
#pragma unroll
        for (int j = 0; j < 4; ++j) { const int col = 256 * j + 4 * F.lane;
            v[j] = (v[j] - mean) * rstd * *(const f32x4*)(F.ln1_w + col) + *(const f32x4*)(F.ln1_b + col); zr[64 * j] = v[j]; }
        row_stats(v, mean, rstd);
        GAS unsigned long long* o8 = (GAS unsigned long long*)(F.H2 + (size_t)m * DM) + F.lane;
#pragma unroll
        for (int j = 0; j < 4; ++j) { const int col = 256 * j + 4 * F.lane;
            const f32x4 sc = *(const f32x4*)(mod + MOD_SC2 + col), sh = *(const f32x4*)(mod + MOD_SH2 + col);
            const f32x4 h = (v[j] - mean) * rstd * (sc + 1.0f) + sh;
            o8[64 * j] = (unsigned long long)pk2(h[0], h[1]) | ((unsigned long long)pk2(h[2], h[3]) << 32); }
    }
}
__device__ __forceinline__ void p10_ln_final(Frame& F) {
    const int gw = blockIdx.x * NWAVES + F.wave, NGW = F.G * NWAVES;
    for (int m = gw; m < M; m += NGW) {
        GAS f32x4* zr = (GAS f32x4*)(F.out + (size_t)m * DM) + F.lane;
        f32x4 v[4];
#pragma unroll
        for (int j = 0; j < 4; ++j) v[j] = zr[64 * j];
        float mean, rstd; row_stats(v, mean, rstd);
#pragma unroll
        for (int j = 0; j < 4; ++j) { const int col = 256 * j + 4 * F.lane;
            zr[64 * j] = (v[j] - mean) * rstd * *(const f32x4*)(F.ln2_w + col) + *(const f32x4*)(F.ln2_b + col); }
    }
}
__device__ __forceinline__ void p3_kmean(Frame& F) {
    LAS float* red = (LAS float*)F.lds;
    const int d = F.tid & 127, rg = F.tid >> 7;
    for (int it = blockIdx.x; it < BATCH * NH * NBLK; it += F.G) {
        const int j = it & 15, h = (it >> 4) & 3, b = it >> 6;
        const bf16* p = F.PROJ + ((size_t)b * SEQ + j * LBLK + rg * 64) * NPROJ + C_MK + h * HD + d;
        float s = 0.f;
#pragma unroll 8
        for (int r = 0; r < 64; ++r) s += bf2f(p[(size_t)r * NPROJ]);
        red[rg * 128 + d] = s;
        __syncthreads();
        if (F.tid < 128) F.KMEAN[(size_t)it * HD + d] = (red[d] + red[128 + d] + red[256 + d] + red[384 + d]) * (1.f / 256.f);
        __syncthreads();
    }
}
__device__ __forceinline__ void ret_simple_chain(Frame& F, int b, int h) {
    const int tid = F.tid, e = tid & 127, dg = tid >> 7, lane = F.lane;
    LAS float* kl = (LAS float*)F.lds;
    LAS float* ql = kl + 256;
    LAS float* part = ql + 256;
    const float gamma = 1.f - exp2f(-5.f - (float)h);
    float S[32];
#pragma unroll
    for (int i = 0; i < 32; ++i) S[i] = 0.f;
    const bf16* base = F.PROJ + (size_t)b * SEQ * NPROJ + h * HD;
    unsigned nk = 0, nq = 0, nv, ng0 = 0, ng1 = 0;
    if (tid < 128) { nk = base[C_RK + tid]; nq = base[C_RQ + tid]; }
    if (tid < 64) { ng0 = base[C_RG + lane]; ng1 = base[C_RG + lane + 64]; }
    nv = base[C_RV + e];
    for (int t = 0; t < SEQ; ++t) {
        const int pb = t & 1;
        if (tid < 128) { kl[pb * 128 + tid] = bf2f(nk); ql[pb * 128 + tid] = bf2f(nq); }
        const float v = bf2f(nv), g0 = bf2f(ng0), g1 = bf2f(ng1);
        if (t + 1 < SEQ) { const bf16* nb = base + (size_t)(t + 1) * NPROJ;
            if (tid < 128) { nk = nb[C_RK + tid]; nq = nb[C_RQ + tid]; }
            if (tid < 64) { ng0 = nb[C_RG + lane]; ng1 = nb[C_RG + lane + 64]; }
            nv = nb[C_RV + e]; }
        __syncthreads();
        float yp = 0.f;
#pragma unroll
        for (int i = 0; i < 32; i += 4) { const f32x4 k4 = *(LAS f32x4*)(kl + pb * 128 + dg * 32 + i), q4 = *(LAS f32x4*)(ql + pb * 128 + dg * 32 + i);
            S[i] = fmaf(gamma, S[i], k4[0] * v); yp = fmaf(q4[0], S[i], yp);
            S[i + 1] = fmaf(gamma, S[i + 1], k4[1] * v); yp = fmaf(q4[1], S[i + 1], yp);
            S[i + 2] = fmaf(gamma, S[i + 2], k4[2] * v); yp = fmaf(q4[2], S[i + 2], yp);
            S[i + 3] = fmaf(gamma, S[i + 3], k4[3] * v); yp = fmaf(q4[3], S[i + 3], yp); }
        part[(pb * 4 + dg) * 128 + e] = yp;
        __syncthreads();
        if (tid < 64) {
            LAS float* pp = part + pb * 512;
            const float y0 = (pp[lane] + pp[128 + lane]) + (pp[256 + lane] + pp[384 + lane]);
            const float y1 = (pp[lane + 64] + pp[128 + lane + 64]) + (pp[256 + lane + 64] + pp[384 + lane + 64]);
            const float mean = wave_sum(y0 + y1) * (1.f / 128.f); const float d0 = y0 - mean, d1 = y1 - mean;
            const float rstd = 1.f / sqrtf(wave_sum(d0 * d0 + d1 * d1) * (1.f / 128.f) + LN_EPS);
            bf16* yo = F.Y + ((size_t)b * SEQ + t) * DM + h * HD;
            yo[lane] = (bf16)f2bf(silu_f(g0) * d0 * rstd); yo[lane + 64] = (bf16)f2bf(silu_f(g1) * d1 * rstd);
        }
    }
    __syncthreads();
}
__device__ __forceinline__ void moba_simple_wave(Frame& F, int qh, LAS float* wl) {
    const int lane = F.lane;
    const int row = qh >> 2, h = qh & 3, b = row >> 12, t = row & 4095, blk = t >> 8;
    const bf16* P = F.PROJ;
    { const unsigned qq = *(const unsigned*)(P + (size_t)row * NPROJ + C_MQ + h * HD + 2 * lane); wl[2 * lane] = bf2f(qq & 0xffffu); wl[2 * lane + 1] = bf2f(qq >> 16); }
    float gate = -INFINITY;
    if (lane < blk) { const float* km = F.KMEAN + (size_t)((b * NH + h) * NBLK + lane) * HD; float g = 0.f;
        for (int d = 0; d < HD; d += 4) { const f32x4 kv = *(const f32x4*)(km + d); const f32x4 qv = *(LAS f32x4*)(wl + d); g += (kv[0] * qv[0] + kv[1] * qv[1]) + (kv[2] * qv[2] + kv[3] * qv[3]); }
        gate = g; }
    const int nsel = blk < 3 ? blk : 3;
    int s0 = 0, s1 = 0, s2 = 0;
#pragma unroll
    for (int s = 0; s < 3; ++s) {
        float bv = gate; int bi = lane;
#pragma unroll
        for (int o = 1; o < 64; o <<= 1) { const float ov = __shfl_xor(bv, o); const int oi = __shfl_xor(bi, o); if (ov > bv || (ov == bv && oi < bi)) { bv = ov; bi = oi; } }
        if (s == 0) s0 = bi; else if (s == 1) s1 = bi; else s2 = bi;
        if (lane == bi) gate = -INFINITY;
    }
    const float slope2 = exp2f(-2.f * (float)(h + 1)) * LOG2E;
    float sc[4][4]; float mx = -INFINITY;
#pragma unroll
    for (int s = 0; s < 4; ++s) {
        const int bid = (s == 0) ? s0 : (s == 1) ? s1 : (s == 2) ? s2 : blk;
        const bool valid = (s == 3) || (s < nsel);
#pragma unroll
        for (int i = 0; i < 4; ++i) {
            float score = -INFINITY;
            if (valid && (s < 3 || i * 64 <= (t & 255))) {
                const int key = bid * LBLK + i * 64 + lane;
                const bf16* kr = P + ((size_t)b * SEQ + key) * NPROJ + C_MK + h * HD;
                float dot = 0.f;
#pragma unroll 4
                for (int d = 0; d < HD; d += 8) { const v4u kk = *(const v4u*)(kr + d); const f32x4 q0 = *(LAS f32x4*)(wl + d), q1 = *(LAS f32x4*)(wl + d + 4);
                    dot += bf2f(kk[0] & 0xffffu) * q0[0] + bf2f(kk[0] >> 16) * q0[1] + bf2f(kk[1] & 0xffffu) * q0[2] + bf2f(kk[1] >> 16) * q0[3]
                         + bf2f(kk[2] & 0xffffu) * q1[0] + bf2f(kk[2] >> 16) * q1[1] + bf2f(kk[3] & 0xffffu) * q1[2] + bf2f(kk[3] >> 16) * q1[3]; }
                const int dist = t - key;
                if (dist >= 0) score = dot - slope2 * (float)dist;
            }
            sc[s][i] = score; mx = fmaxf(mx, score);
        }
    }
    mx = wave_max(mx);
    float l = 0.f;
#pragma unroll
    for (int s = 0; s < 4; ++s)
#pragma unroll
        for (int i = 0; i < 4; ++i) { sc[s][i] = __builtin_amdgcn_exp2f(sc[s][i] - mx); l += sc[s][i]; }
    l = wave_sum(l);
    float o0 = 0.f, o1 = 0.f;
#pragma unroll
    for (int s = 0; s < 4; ++s) {
        const int bid = (s == 0) ? s0 : (s == 1) ? s1 : (s == 2) ? s2 : blk;
        const bool valid = (s == 3) || (s < nsel);
#pragma unroll
        for (int i = 0; i < 4; ++i) {
            if (valid && (s < 3 || i * 64 <= (t & 255))) {
                wl[128 + lane] = sc[s][i];
                const bf16* vr = P + ((size_t)b * SEQ + bid * LBLK + i * 64) * NPROJ + C_MV + h * HD + 2 * lane;
#pragma unroll 8
                for (int kk = 0; kk < 64; ++kk) { const float p = wl[128 + kk]; const unsigned vv = *(const unsigned*)(vr + (size_t)kk * NPROJ);
                    o0 = fmaf(p, bf2f(vv & 0xffffu), o0); o1 = fmaf(p, bf2f(vv >> 16), o1); }
            }
        }
    }
    const float rl = 1.f / l;
    *(unsigned*)(F.Y + (size_t)row * DM + 512 + h * HD + 2 * lane) = pk2(o0 * rl, o1 * rl);
}
__device__ __forceinline__ void p5_mixers_simple(Frame& F) {
    if (blockIdx.x < BATCH * NH) ret_simple_chain(F, blockIdx.x >> 2, blockIdx.x & 3);
    LAS float* wl = (LAS float*)(F.lds + 8192) + F.wave * 192;
    const int gw = blockIdx.x * NWAVES + F.wave, NGW = F.G * NWAVES;
    for (int qh = gw; qh < M * NH; qh += NGW) moba_simple_wave(F, qh, wl);
}

constexpr int N_PHASES = 11;
#ifndef MK_N_LAUNCHES
#define MK_N_LAUNCHES 1
#endif
constexpr int N_LAUNCHES = MK_N_LAUNCHES;
struct Args { const float* in[12]; float* out; unsigned char* ws; int ph_lo, ph_hi; };
__global__ void __launch_bounds__(NWAVES * 64, 2) fwd_kernel(Args args) {
    extern __shared__ __attribute__((aligned(16))) unsigned char lds[];
    Frame F;
    F.lds = (LAS unsigned char*)lds;
    F.MISC = (volatile LAS unsigned*)(F.lds + MISC_OFF);
    F.tid = threadIdx.x; F.lane = F.tid & 63; F.wave = __builtin_amdgcn_readfirstlane(F.tid >> 6); F.G = gridDim.x;
    unsigned char* ws = args.ws;
    F.ctl = (gu32*)(ws + WS_CTL);
    F.x = args.in[0]; F.c = args.in[1]; F.w_ada = args.in[2]; F.b_ada = args.in[3]; F.w_in = args.in[4]; F.w_out = args.in[5];
    F.ln1_w = args.in[6]; F.ln1_b = args.in[7]; F.w_fi = args.in[8]; F.w_fo = args.in[9]; F.ln2_w = args.in[10]; F.ln2_b = args.in[11];
    F.out = args.out;
    F.MOD = (float*)(ws + WS_MOD); F.KMEAN = (float*)(ws + WS_KMEAN);
    F.WIN = (bf16*)(ws + WS_WIN); F.WOUT = (bf16*)(ws + WS_WOUT); F.WFI = (bf16*)(ws + WS_WFI); F.WFO = (bf16*)(ws + WS_WFO);
    F.H1 = (bf16*)(ws + WS_H1); F.PROJ = (bf16*)(ws + WS_PROJ); F.HID = (bf16*)(ws + WS_HID); F.Y = (bf16*)(ws + WS_Y); F.H2 = (bf16*)(ws + WS_H2);
    for (int u = F.tid; u < (LDS_BYTES - LDSCTL_OFF) / 4; u += NWAVES * 64) ((LAS unsigned*)(F.lds + LDSCTL_OFF))[u] = 0u;
    __syncthreads();
    XcdBarrier bar; bar.bar = (unsigned*)(F.ctl + CW_BAR); bar.x = 0; bar.st = nullptr;
    if (N_LAUNCHES == 1) bar = xcd_barrier_post((unsigned*)(F.ctl + CW_BAR), F.MISC + 8);
#define GRID_BAR() do { if (N_LAUNCHES == 1) xcd_barrier(bar); } while (0)
    const int lo = args.ph_lo, hi = args.ph_hi;
#define IN(k) (lo <= (k) && (k) < hi)
#define BOTH(k) (IN(k) && IN((k) + 1))
    if (IN(0)) { p0_prologue(F); if (BOTH(0)) GRID_BAR(); }
    if (IN(1)) { p1_ln_mod(F); if (BOTH(1)) GRID_BAR(); }
    if (IN(2)) {
        pg8::Gemm g{F.H1, F.WIN, M, NPROJ, DM}; pg8::StaticOrder S; S.init(M, NPROJ, F.G, (int)blockIdx.x);
        pg8::EpiProj E{F.PROJ, NPROJ, RSQD, RSQD * LOG2E};
        pg8::gemm_phase<pg8::EpiProj, pg8::StaticOrder, true, true>(F.lds + RING_OFF, g, S, E);
        if (BOTH(2)) GRID_BAR();
    }
    if (IN(3)) { p3_kmean(F); if (BOTH(3)) GRID_BAR(); }
    if (IN(4)) { if (BOTH(4)) GRID_BAR(); }
    if (IN(5)) { p5_mixers_simple(F); if (BOTH(5)) GRID_BAR(); }
    if (IN(6)) {
        pg8::Gemm g{F.Y, F.WOUT, M, DM, DM}; pg8::StaticOrder S; S.init(M, DM, F.G, (int)blockIdx.x);
        pg8::EpiRes E{F.x, F.out, F.MOD + MOD_G1, NADA, ALPHA};
        pg8::gemm_phase<pg8::EpiRes, pg8::StaticOrder, true, true>(F.lds + RING_OFF, g, S, E);
        if (BOTH(6)) GRID_BAR();
    }
    if (IN(7)) { p7_ln_ln(F); if (BOTH(7)) GRID_BAR(); }
    if (IN(8)) {
        pg8::Gemm g{F.H2, F.WFI, M, NFI, DM}; pg8::StaticOrder S; S.init(M, NFI, F.G, (int)blockIdx.x);
        pg8::EpiSwiGLU E{F.HID, DFF};
        pg8::gemm_phase<pg8::EpiSwiGLU, pg8::StaticOrder, true, true>(F.lds + RING_OFF, g, S, E);
        if (BOTH(8)) GRID_BAR();
    }
    if (IN(9)) {
        pg8::Gemm g{F.HID, F.WFO, M, DM, DFF}; pg8::StaticOrder S; S.init(M, DM, F.G, (int)blockIdx.x);
        pg8::EpiRes E{F.out, F.out, F.MOD + MOD_G2, NADA, ALPHA};
        pg8::gemm_phase<pg8::EpiRes, pg8::StaticOrder, true, true>(F.lds + RING_OFF, g, S, E);
        if (BOTH(9)) GRID_BAR();
    }
    if (IN(10)) { p10_ln_final(F); }
#undef IN
#undef BOTH
}

extern "C" void kernel_launch(void* const* d_in, const int* in_sizes, int n_in, void* d_out, int out_size, void* d_ws, size_t ws_size, hipStream_t stream) {
    static int grid = 0;
    if (grid == 0) {
        if (n_in != 12 || in_sizes[0] != M * DM || out_size != M * DM || ws_size < WS_END) {
            fprintf(stderr, "kernel_launch: shape mismatch (n_in %d, in0 %d, out %d, ws %zu; need ws >= %zu); nothing launched\n", n_in, n_in > 0 ? in_sizes[0] : -1, out_size, ws_size, (size_t)WS_END); grid = -1; return; }
        int dev = 0, cus = 0, per_cu = 0;
        if (hipGetDevice(&dev) != hipSuccess || hipDeviceGetAttribute(&cus, hipDeviceAttributeMultiprocessorCount, dev) != hipSuccess) { fprintf(stderr, "kernel_launch: device query failed\n"); grid = -1; return; }
        if (hipFuncSetAttribute((const void*)fwd_kernel, hipFuncAttributeMaxDynamicSharedMemorySize, LDS_BYTES) != hipSuccess) { fprintf(stderr, "kernel_launch: hipFuncSetAttribute failed\n"); grid = -1; return; }
        if (hipOccupancyMaxActiveBlocksPerMultiprocessor(&per_cu, (const void*)fwd_kernel, NWAVES * 64, LDS_BYTES) != hipSuccess || per_cu < 1)
            fprintf(stderr, "kernel_launch: note: occupancy query reports %d workgroups per CU\n", per_cu);
        (void)hipGetLastError();
        grid = cus;
        if (grid != 256) fprintf(stderr, "kernel_launch: note: %d CUs (built for 256)\n", grid);
    }
    if (grid < 0) return;
    if (hipMemsetAsync((char*)d_ws + WS_CTL, 0, CTL_ZERO_BYTES, stream) != hipSuccess) { fprintf(stderr, "kernel_launch: memset failed\n"); return; }
    Args a{};
    for (int i = 0; i < 12; ++i) a.in[i] = (const float*)d_in[i];
    a.out = (float*)d_out; a.ws = (unsigned char*)d_ws;
    for (int li = 0; li < N_LAUNCHES; ++li) {
        a.ph_lo = (N_LAUNCHES == 1) ? 0 : li; a.ph_hi = (N_LAUNCHES == 1) ? N_PHASES : li + 1;
        hipLaunchKernelGGL(fwd_kernel, dim3(grid), dim3(NWAVES * 64), LDS_BYTES, stream, a);
        const hipError_t le = hipPeekAtLastError();
        if (le != hipSuccess) { fprintf(stderr, "kernel_launch: launch %d failed: %s\n", li, hipGetErrorName(le)); break; }
    }
}
```

```cpp
#include <hip/hip_runtime.h>
#include <cstdio>
#include <cstdint>
#include <cmath>
namespace pg8 {
#define PG8_LAS __attribute__((address_space(3)))
typedef unsigned short bf16_t;
typedef short bf16x8 __attribute__((ext_vector_type(8)));
typedef float f32x4 __attribute__((ext_vector_type(4)));
typedef unsigned u32x4 __attribute__((ext_vector_type(4)));
constexpr int BM = 256, BK = 64, HALF = 128, HTB = HALF * BK * 2  , STAGE_BYTES = 8 * HTB, NXCD = 8, WGM = 8;

__host__ __device__ __forceinline__ int lds_byte(int r, int c) { const int st = (r >> 4) * 2 + (c >> 5), rr = r & 15, cc = c & 31, ob = rr * 64 + cc * 2; return st * 1024 + (ob ^ (((ob >> 9) & 1) << 5)); }
__host__ __device__ __forceinline__ void stage_rc(int b, int& R, int& C) { const int st = b / 1024, sb = b % 1024, swz = sb ^ (((sb >> 9) & 1) << 5); R = (st >> 1) * 16 + swz / 64; C = (st & 1) * 32 + (swz % 64) / 2; }
__host__ __device__ __forceinline__ int perm32(int rho) { const int n = rho >> 4, i = rho & 15; return 8 * (i >> 2) + 4 * n + (i & 3); }

struct Unit { int pm, pn; };
struct Gemm { const bf16_t* A; const bf16_t* Bt; int M, N, K; };

struct StaticOrder {
    int nM, nN, nwg, G, c;
    __host__ __device__ void init(int M, int N, int G_, int c_) { nM = M / BM; nN = N / BM; nwg = nM * nN; G = G_; c = c_; }
    __host__ __device__ bool next(int i, Unit& u) const {
        const long L = (long)i * G + c; if (L >= nwg) return false;
        int wgid = (int)L; { const int q = nwg / NXCD, r = nwg % NXCD, xcd = wgid % NXCD, off = wgid / NXCD; wgid = (xcd < r ? xcd * (q + 1) : r * (q + 1) + (xcd - r) * q) + off; }
        const int nig = WGM * nN, gid = wgid / nig, fm = gid * WGM, gsz = (nM - fm) < WGM ? (nM - fm) : WGM;
        u.pm = fm + ((wgid % nig) % gsz); u.pn = (wgid % nig) / gsz; return true;
    }
    __device__ __forceinline__ void a_ready(const Unit&) const {}
    __device__ __forceinline__ void done(const Unit&) const {}
};

__device__ __forceinline__ unsigned cvt_pk_bf16(float lo, float hi) { unsigned r; asm volatile("v_cvt_pk_bf16_f32 %0, %1, %2" : "=v"(r) : "v"(lo), "v"(hi)); return r; }
typedef float f32x2 __attribute__((ext_vector_type(2)));
struct EpiProj {
    static constexpr bool PERM = true, AFTER_DRAIN = false;
    bf16_t* O; int ldc; float s_rk, s_mq;
    __device__ __forceinline__ void operator()(const f32x4 (&acc)[2][2][4][2], const Unit& u, int wr, int wc, int fr, int fq) const {
        const int row0 = u.pm * BM + wr * 64 + fr, col0 = u.pn * BM + wc * 32 + 8 * fq;
        const float sc = (u.pn == 2 || u.pn == 3) ? s_rk : ((u.pn == 8 || u.pn == 9) ? s_mq : 1.0f);
#pragma unroll
        for (int ai = 0; ai < 2; ++ai)
#pragma unroll
            for (int m = 0; m < 4; ++m) { bf16_t* rowp = O + (size_t)(row0 + ai * HALF + m * 16) * ldc + col0;
#pragma unroll
                for (int bj = 0; bj < 2; ++bj) { const f32x4 v0 = acc[ai][bj][m][0] * sc, v1 = acc[ai][bj][m][1] * sc;
                    u32x4 w; w.x = cvt_pk_bf16(v0[0], v0[1]); w.y = cvt_pk_bf16(v0[2], v0[3]); w.z = cvt_pk_bf16(v1[0], v1[1]); w.w = cvt_pk_bf16(v1[2], v1[3]);
                    *(u32x4*)(rowp + bj * HALF) = w; } }
    }
};
struct EpiRes {
    static constexpr bool PERM = false, AFTER_DRAIN = false;
    const float* base; float* out; const float* gate; int gate_stride; float alpha;
    __device__ __forceinline__ void operator()(const f32x4 (&acc)[2][2][4][2], const Unit& u, int wr, int wc, int fr, int fq) const {
        const int row0 = u.pm * BM + wr * 64 + fr, col0 = u.pn * BM + wc * 32 + 4 * fq;
        const float* g = gate + (size_t)(u.pm >> 4) * gate_stride + col0;
        f32x4 gv[2][2];
#pragma unroll
        for (int bj = 0; bj < 2; ++bj)
#pragma unroll
            for (int n = 0; n < 2; ++n) gv[bj][n] = *(const f32x4*)(g + bj * HALF + n * 16);
#pragma unroll
        for (int ai = 0; ai < 2; ++ai)
#pragma unroll
            for (int m = 0; m < 4; ++m) { const size_t off = (size_t)(row0 + ai * HALF + m * 16) * 1024 + col0;
#pragma unroll
                for (int bj = 0; bj < 2; ++bj)
#pragma unroll
                    for (int n = 0; n < 2; ++n) { const f32x4 bs = *(const f32x4*)(base + off + bj * HALF + n * 16);
                        *(f32x4*)(out + off + bj * HALF + n * 16) = bs * alpha + gv[bj][n] * acc[ai][bj][m][n]; }
                if (m & 1) asm volatile("" ::: "memory"); }
    }
};
struct EpiSwiGLU {
    static constexpr bool PERM = true, AFTER_DRAIN = false;
    bf16_t* O; int ldc;
    __device__ __forceinline__ void operator()(const f32x4 (&acc)[2][2][4][2], const Unit& u, int wr, int wc, int fr, int fq) const {
        const int row0 = u.pm * BM + wr * 64 + fr, col0 = u.pn * HALF + wc * 32 + 8 * fq;
#pragma unroll
        for (int ai = 0; ai < 2; ++ai)
#pragma unroll
            for (int m = 0; m < 4; ++m) { bf16_t* rowp = O + (size_t)(row0 + ai * HALF + m * 16) * ldc + col0;
                float h[8];
#pragma unroll
                for (int n = 0; n < 2; ++n)
#pragma unroll
                    for (int i = 0; i < 4; ++i) { const float gt = acc[ai][0][m][n][i], up = acc[ai][1][m][n][i];
                        h[n * 4 + i] = gt * __builtin_amdgcn_rcpf(1.0f + __builtin_amdgcn_exp2f(-1.4426950408889634f * gt)) * up; }
                u32x4 w; w.x = cvt_pk_bf16(h[0], h[1]); w.y = cvt_pk_bf16(h[2], h[3]); w.z = cvt_pk_bf16(h[4], h[5]); w.w = cvt_pk_bf16(h[6], h[7]);
                *(u32x4*)rowp = w; }
    }
};
template <class Epi, class Sched, bool ALIGN_EPI = false, bool SP2 = false>
__device__ __forceinline__ void gemm_phase(PG8_LAS unsigned char* lds, const Gemm g, const Sched& S, const Epi& E) {
    const int tid = threadIdx.x, wid = __builtin_amdgcn_readfirstlane(tid >> 6), lane = tid & 63, wr = wid >> 2, wc = wid & 3, fr = lane & 15, fq = lane >> 4;
    const int K = g.K, nt = K / BK;
    unsigned voffA[2], voffB[2];
#pragma unroll
    for (int i = 0; i < 2; ++i) { int R, C; stage_rc(tid * 16 + i * 8192, R, C); const int Rb = Epi::PERM ? ((R & ~31) + perm32(R & 31)) : R;
        voffA[i] = (unsigned)(R * K + C) * 2u; voffB[i] = (unsigned)(Rb * K + C) * 2u; }
    const size_t kstep = (size_t)(BK * 2);
    const size_t hstep = (size_t)HALF * K * 2;
    const size_t tstep = 2 * hstep;
    const unsigned ldsw = (unsigned)wid * 1024u;
    const int aoff = lds_byte(wr * 64 + fr, fq * 8), boff = lds_byte(wc * 32 + fr, fq * 8);
#define PG8_SA(b, h) (((b) * 2 + (h)) * HTB)
#define PG8_SB(b, h) ((4 + (b) * 2 + (h)) * HTB)
#define PG8_STAGE(bufoff, gbase, voff) do { _Pragma("unroll") for (int _i = 0; _i < 2; ++_i) \
        __builtin_amdgcn_global_load_lds((const unsigned*)((const char*)(gbase) + (voff)[_i]), (PG8_LAS unsigned*)(lds + (bufoff) + ldsw + _i * 8192), 16, 0, 0); } while (0)
#define PG8_LDA(dst, b, h) do { _Pragma("unroll") for (int m = 0; m < 4; ++m) _Pragma("unroll") for (int k = 0; k < 2; ++k) dst[m][k] = *(const PG8_LAS bf16x8*)(lds + PG8_SA(b, h) + aoff + m * 2048 + k * 1024); } while (0)
#define PG8_LDB(dst, b, h) do { _Pragma("unroll") for (int n = 0; n < 2; ++n) _Pragma("unroll") for (int k = 0; k < 2; ++k) dst[n][k] = *(const PG8_LAS bf16x8*)(lds + PG8_SB(b, h) + boff + n * 2048 + k * 1024); } while (0)
#define PG8_MMA(ai, bj, At, Bt) do { __builtin_amdgcn_s_setprio(1); _Pragma("unroll") for (int m = 0; m < 4; ++m) _Pragma("unroll") for (int n = 0; n < 2; ++n) _Pragma("unroll") for (int k = 0; k < 2; ++k) \
        acc[ai][bj][m][n] = __builtin_amdgcn_mfma_f32_16x16x32_bf16(Bt[n][k], At[m][k], acc[ai][bj][m][n], 0, 0, 0); __builtin_amdgcn_s_setprio(0); } while (0)
#define PG8_WAIT_V(n) asm volatile("s_waitcnt vmcnt(" #n ")" ::: "memory")
#define PG8_WAIT_L(n) asm volatile("s_waitcnt lgkmcnt(" #n ")" ::: "memory")
#define PG8_BAR __builtin_amdgcn_s_barrier()
#define PG8_SCHED __builtin_amdgcn_sched_barrier(0)
    Unit cur, nxt; int ui = 0;
    if (!S.next(0, cur)) return;
    f32x4 acc[2][2][4][2];
#pragma unroll
    for (int a = 0; a < 2; ++a)
#pragma unroll
        for (int b = 0; b < 2; ++b)
#pragma unroll
            for (int m = 0; m < 4; ++m)
#pragma unroll
                for (int n = 0; n < 2; ++n) acc[a][b][m][n] = (f32x4){0.f, 0.f, 0.f, 0.f};
    bf16x8 At[4][2], B0[2][2], B1[2][2];
    const char* cA = (const char*)g.A + (size_t)cur.pm * tstep; const char* cB = (const char*)g.Bt + (size_t)cur.pn * tstep;
    S.a_ready(cur);
    if constexpr (SP2) {
        PG8_STAGE(PG8_SB(0, 0), cB, voffB); PG8_STAGE(PG8_SB(0, 1), cB + hstep, voffB); PG8_STAGE(PG8_SA(0, 0), cA, voffA); PG8_STAGE(PG8_SA(0, 1), cA + hstep, voffA);
        if (wr == 1) PG8_BAR;
        PG8_WAIT_V(2); PG8_BAR;
        PG8_STAGE(PG8_SB(1, 0), cB + kstep, voffB); PG8_STAGE(PG8_SA(1, 0), cA + kstep, voffA); PG8_STAGE(PG8_SB(1, 1), cB + hstep + kstep, voffB);
        PG8_WAIT_V(6); PG8_BAR;
    } else {
        PG8_STAGE(PG8_SB(0, 0), cB, voffB); PG8_STAGE(PG8_SA(0, 0), cA, voffA); PG8_STAGE(PG8_SB(0, 1), cB + hstep, voffB); PG8_STAGE(PG8_SA(0, 1), cA + hstep, voffA);
        if (wr == 1) PG8_BAR;
        PG8_WAIT_V(4); PG8_BAR;
        PG8_STAGE(PG8_SB(1, 0), cB + kstep, voffB); PG8_STAGE(PG8_SA(1, 0), cA + kstep, voffA); PG8_STAGE(PG8_SB(1, 1), cB + hstep + kstep, voffB);
        PG8_WAIT_V(6); PG8_BAR;
    }
    for (;;) {
        const bool has_next = S.next(ui + 1, nxt);
        const char* nA = has_next ? (const char*)g.A + (size_t)nxt.pm * tstep : cA; const char* nB = has_next ? (const char*)g.Bt + (size_t)nxt.pn * tstep : cB;
        for (int t = 0; t < nt; t += 2) {
            const bool last = (t == nt - 2);
            const char* a1 = cA + (size_t)(t + 1) * kstep;
            const char* a2 = last ? nA : cA + (size_t)(t + 2) * kstep; const char* b2 = last ? nB : cB + (size_t)(t + 2) * kstep;
            const char* a3 = a2 + kstep; const char* b3 = b2 + kstep;
            if (last && has_next) S.a_ready(nxt);
            if constexpr (SP2) {
            PG8_LDB(B0, 0, 0); PG8_LDB(B1, 0, 1); PG8_SCHED; PG8_LDA(At, 0, 0); PG8_STAGE(PG8_SA(1, 1), a1 + hstep, voffA);
            PG8_WAIT_V(8); PG8_WAIT_L(0); PG8_BAR; PG8_MMA(0, 0, At, B0); PG8_MMA(0, 1, At, B1); PG8_BAR; PG8_SCHED;
            PG8_LDA(At, 0, 1); PG8_STAGE(PG8_SB(0, 0), b2, voffB); PG8_STAGE(PG8_SB(0, 1), b2 + hstep, voffB); PG8_STAGE(PG8_SA(0, 0), a2, voffA);
            PG8_WAIT_V(8); PG8_WAIT_L(0); PG8_BAR; PG8_MMA(1, 0, At, B0); PG8_MMA(1, 1, At, B1); PG8_BAR; PG8_SCHED;
            PG8_LDB(B0, 1, 0); PG8_LDB(B1, 1, 1); PG8_SCHED; PG8_LDA(At, 1, 0); PG8_STAGE(PG8_SA(0, 1), a2 + hstep, voffA);
            PG8_WAIT_V(8); PG8_WAIT_L(0); PG8_BAR; PG8_MMA(0, 0, At, B0); PG8_MMA(0, 1, At, B1); PG8_BAR; PG8_SCHED;
            PG8_LDA(At, 1, 1); PG8_STAGE(PG8_SB(1, 0), b3, voffB); PG8_STAGE(PG8_SB(1, 1), b3 + hstep, voffB); PG8_STAGE(PG8_SA(1, 0), a3, voffA);
            PG8_WAIT_V(8); PG8_WAIT_L(0); PG8_BAR; PG8_MMA(1, 0, At, B0); PG8_MMA(1, 1, At, B1); PG8_BAR; PG8_SCHED;
            } else {
            PG8_LDB(B0, 0, 0); PG8_SCHED; PG8_LDA(At, 0, 0); PG8_STAGE(PG8_SA(1, 1), a1 + hstep, voffA);
            PG8_WAIT_L(8); PG8_BAR; PG8_WAIT_L(0); PG8_MMA(0, 0, At, B0); PG8_BAR; PG8_SCHED;
            PG8_LDB(B1, 0, 1); PG8_STAGE(PG8_SB(0, 0), b2, voffB);
            PG8_BAR; PG8_WAIT_L(0); PG8_MMA(0, 1, At, B1); PG8_BAR;
            PG8_LDA(At, 0, 1); PG8_STAGE(PG8_SA(0, 0), a2, voffA);
            PG8_BAR; PG8_WAIT_L(0); PG8_MMA(1, 0, At, B0); PG8_BAR; PG8_SCHED;
            PG8_STAGE(PG8_SB(0, 1), b2 + hstep, voffB);
            PG8_WAIT_V(6); PG8_BAR; PG8_MMA(1, 1, At, B1); PG8_BAR;
            PG8_LDB(B0, 1, 0); PG8_SCHED; PG8_LDA(At, 1, 0); PG8_STAGE(PG8_SA(0, 1), a2 + hstep, voffA);
            PG8_WAIT_L(8); PG8_BAR; PG8_WAIT_L(0); PG8_MMA(0, 0, At, B0); PG8_BAR; PG8_SCHED;
            PG8_LDB(B1, 1, 1); PG8_STAGE(PG8_SB(1, 0), b3, voffB);
            PG8_BAR; PG8_WAIT_L(0); PG8_MMA(0, 1, At, B1); PG8_BAR;
            PG8_LDA(At, 1, 1); PG8_STAGE(PG8_SA(1, 0), a3, voffA);
            PG8_BAR; PG8_WAIT_L(0); PG8_MMA(1, 0, At, B0); PG8_BAR; PG8_SCHED;
            PG8_STAGE(PG8_SB(1, 1), b3 + hstep, voffB);
            PG8_WAIT_V(6); PG8_BAR; PG8_MMA(1, 1, At, B1); PG8_BAR;
            }
        }
        if constexpr (ALIGN_EPI) { if (wr == 0) PG8_BAR; }
        if constexpr (!Epi::AFTER_DRAIN) { E(acc, cur, wr, wc, fr, fq); S.done(cur); }
        if (!has_next) break;
#pragma unroll
        for (int a = 0; a < 2; ++a)
#pragma unroll
            for (int b = 0; b < 2; ++b)
#pragma unroll
                for (int m = 0; m < 4; ++m)
#pragma unroll
                    for (int n = 0; n < 2; ++n) acc[a][b][m][n] = (f32x4){0.f, 0.f, 0.f, 0.f};
        cur = nxt; cA = nA; cB = nB; ++ui;
        if constexpr (ALIGN_EPI) { if (wr == 1) PG8_BAR; }
    }
    PG8_WAIT_V(0);
    if constexpr (!ALIGN_EPI) { if (wr == 0) PG8_BAR; }
    PG8_BAR;
    if constexpr (Epi::AFTER_DRAIN) { E.fused(acc, cur, wr, wc, fr, fq, lds, wid, lane); S.done(cur); }
#undef PG8_SA
#undef PG8_SB
#undef PG8_STAGE
#undef PG8_LDA
#undef PG8_LDB
#undef PG8_MMA
#undef PG8_WAIT_V
#undef PG8_WAIT_L
#undef PG8_BAR
#undef PG8_SCHED
}
}
#define GAS __attribute__((address_space(1)))
#define LAS __attribute__((address_space(3)))
typedef unsigned short bf16;
typedef unsigned v4u __attribute__((ext_vector_type(4)));
typedef float f32x4 __attribute__((ext_vector_type(4)));
typedef short bf16x8 __attribute__((ext_vector_type(8)));
typedef GAS unsigned gu32;
typedef GAS unsigned long long gu64;
#define RLX_AGENT __ATOMIC_RELAXED, __HIP_MEMORY_SCOPE_AGENT
#define LDS_WAIT() asm volatile("s_waitcnt lgkmcnt(0)" ::: "memory")
#define VM_WAIT() asm volatile("s_waitcnt vmcnt(0)" ::: "memory")
__device__ __forceinline__ unsigned long long rt() { return __builtin_amdgcn_s_memrealtime(); }
__device__ __forceinline__ unsigned f2bf(float f) { unsigned u = __builtin_bit_cast(unsigned, f); return (u + 0x7fffu + ((u >> 16) & 1u)) >> 16; }
__device__ __forceinline__ unsigned pk2(float lo, float hi) { return f2bf(lo) | (f2bf(hi) << 16); }
#define XB_TMO      128
#define XB_XCNT(j)  (256  + 64 * (j))
#define XB_XSUB(j)  (1280 + 64 * (j))
#define XB_XGEN(j)  (2304 + 64 * (j))
#define XB_TOP      3328
#define XB_TOPGEN   3392
#define XCD_BAR_WORDS 3456
#define XB_SPIN_CAP (1u << 18)

__device__ __forceinline__ unsigned xb_ld(unsigned* p)              { return __hip_atomic_load(p, __ATOMIC_RELAXED, __HIP_MEMORY_SCOPE_AGENT); }
__device__ __forceinline__ unsigned xb_add(unsigned* p, unsigned v) { return __hip_atomic_fetch_add(p, v, __ATOMIC_RELAXED, __HIP_MEMORY_SCOPE_AGENT); }
__device__ __forceinline__ unsigned xb_xcc_id() { return (unsigned)__builtin_amdgcn_s_getreg((3 << 11) | 20) & 0xFu; }
#define XB_SPIN(cond, bar) do { unsigned _sp = 0; while (cond) { __builtin_amdgcn_s_sleep(1); \
    if ((++_sp & 255u) == 0u) { if (xb_ld(&(bar)[XB_TMO])) break; if (_sp > XB_SPIN_CAP) { atomicAdd(&(bar)[XB_TMO], 1u); break; } } } } while (0)

struct XcdBarrier {
    unsigned* bar; unsigned x;
    volatile LAS unsigned* st;
};

__device__ __forceinline__ XcdBarrier xcd_barrier_post(unsigned* bar, volatile LAS unsigned* st) {
    XcdBarrier b; b.bar = bar; b.x = xb_xcc_id(); b.st = st;
    if (threadIdx.x == 0) (void)xb_add(&bar[XB_XCNT(b.x)], 1u);
    return b;
}
__device__ __forceinline__ void xcd_barrier_complete(unsigned* bar, unsigned x, unsigned& nloc, unsigned& nx) {
    const unsigned G = gridDim.x * gridDim.y * gridDim.z;
    unsigned sum, cnt, mine, sp = 0u;
    for (;;) {
        sum = 0u; cnt = 0u; mine = 0u;
#pragma unroll
        for (unsigned j = 0; j < 16; ++j) { const unsigned c = xb_ld(&bar[XB_XCNT(j)]); sum += c; cnt += (c > 0u) ? 1u : 0u; mine = (j == x) ? c : mine; }
        if (sum == G) break;
        __builtin_amdgcn_s_sleep(1);
        if ((++sp & 255u) == 0u) { if (xb_ld(&bar[XB_TMO])) break; if (sp > XB_SPIN_CAP) { atomicAdd(&bar[XB_TMO], 1u); break; } }
    }
    nloc = mine > 0u ? mine : 1u; nx = cnt > 0u ? cnt : 1u;
}

__device__ __forceinline__ void xcd_barrier(const XcdBarrier& b) {
    asm volatile("s_waitcnt vmcnt(0)" ::: "memory");
    __syncthreads();
    if (threadIdx.x == 0) {
        unsigned* bar = b.bar;
        __builtin_amdgcn_s_waitcnt(0);
        unsigned nloc = b.st[0], nx = b.st[1];
        if (nloc == 0u) { xcd_barrier_complete(bar, b.x, nloc, nx); b.st[0] = nloc; b.st[1] = nx; }
        const unsigned old = xb_add(&bar[XB_XSUB(b.x)], 1u);
        const unsigned gen = old / nloc;
        if (old + 1u == (gen + 1u) * nloc) {
            __builtin_amdgcn_fence(__ATOMIC_RELEASE, "agent");
            asm volatile("s_waitcnt vmcnt(0)" ::: "memory");
            const unsigned og = xb_add(&bar[XB_TOP], 1u);
            const unsigned tg = og / nx;
            if (og + 1u == (tg + 1u) * nx) xb_add(&bar[XB_TOPGEN], 1u);
            else XB_SPIN(xb_ld(&bar[XB_TOPGEN]) == tg, bar);
            __builtin_amdgcn_fence(__ATOMIC_ACQUIRE, "agent");
            xb_add(&bar[XB_XGEN(b.x)], 1u);
            asm volatile("s_waitcnt vmcnt(0)" ::: "memory");
        } else {
            XB_SPIN(xb_ld(&bar[XB_XGEN(b.x)]) == gen, bar);
            __builtin_amdgcn_fence(__ATOMIC_ACQUIRE, "agent");
            asm volatile("s_waitcnt vmcnt(0)" ::: "memory");
        }
    }
    __syncthreads();
}
__device__ __forceinline__ float wave_sum(float v) {
#pragma unroll
    for (int o = 1; o < 64; o <<= 1) v += __shfl_xor(v, o);
    return v;
}
__device__ __forceinline__ void p0_transpose_item(const float* W, int K, int N, bf16* WT, int row_off, LAS float* scr, int item, int lane) {
    const int nblk = N / 32, kb = item / nblk, nb = item % nblk, k0 = 64 * kb, n0 = 32 * nb;
#pragma unroll 8
    for (int i = 0; i < 32; ++i) { const int kk = 2 * i + (lane >> 5); scr[kk * 33 + (lane & 31)] = W[(size_t)(k0 + kk) * N + n0 + (lane & 31)]; }
    LDS_WAIT(); asm volatile("" ::: "memory");
    const int c = lane & 7;
#pragma unroll
    for (int j = 0; j < 4; ++j) { const int n = (lane >> 3) + 8 * j; const LAS float* s = scr + (8 * c) * 33 + n;
        v4u o; o.x = pk2(s[0 * 33], s[1 * 33]); o.y = pk2(s[2 * 33], s[3 * 33]); o.z = pk2(s[4 * 33], s[5 * 33]); o.w = pk2(s[6 * 33], s[7 * 33]);
        *(GAS v4u*)(WT + (size_t)(row_off + n0 + n) * K + k0 + 8 * c) = o; }
    LDS_WAIT(); asm volatile("" ::: "memory");
}

constexpr int NWAVES = 8;
constexpr int BATCH = 8, SEQ = 4096, DM = 1024, M = BATCH * SEQ;
constexpr int NPROJ = 3584, DFF = 2816, NFI = 2 * DFF, NADA = 6 * DM;
constexpr int C_RQ = 0, C_RK = 512, C_RV = 1024, C_RG = 1536, C_MQ = 2048, C_MK = 2560, C_MV = 3072;
constexpr int NH = 4, HD = 128, NBLK = 16, LBLK = 256;
constexpr float LN_EPS = 1e-5f;
constexpr float ALPHA = 1.189207115002721f;
constexpr float RSQD = 0.08838834764831845f;
constexpr float LOG2E = 1.4426950408889634f;
constexpr int MOD_SH1 = 0, MOD_SC1 = 1024, MOD_G1 = 2048, MOD_SH2 = 3072, MOD_SC2 = 4096, MOD_G2 = 5120;

constexpr size_t MiB = 1u << 20;
constexpr size_t WS_CTL = 0, CTL_ZERO_BYTES = 1 * MiB;
constexpr size_t WS_MOD = 1 * MiB;
constexpr size_t WS_KMEAN = 1 * MiB + 256 * 1024;
constexpr size_t WS_WIN = 2 * MiB, WS_WOUT = 9 * MiB, WS_WFI = 11 * MiB, WS_WFO = 22 * MiB;
constexpr size_t WS_H1 = 32 * MiB;
constexpr size_t WS_PROJ = 96 * MiB;
constexpr size_t WS_HID = 96 * MiB;
constexpr size_t WS_Y = 320 * MiB;
constexpr size_t WS_H2 = 384 * MiB;
constexpr size_t WS_END = 448 * MiB;
constexpr int CW_TMO = 0, CW_CODE = 1, CW_BAR = 4096;

constexpr int RING_OFF = 0, RING_BYTES = 131072;
constexpr int LDSCTL_OFF = RING_BYTES, MISC_OFF = LDSCTL_OFF + 320;
constexpr int LDS_BYTES = 147456;

struct Frame {
    LAS unsigned char* lds;
    volatile LAS unsigned* MISC;
    gu32* ctl;
    int tid, lane, wave, G;
    const float *x, *c, *w_ada, *b_ada, *w_in, *w_out, *ln1_w, *ln1_b, *w_fi, *w_fo, *ln2_w, *ln2_b;
    float* out;
    float *MOD, *KMEAN;
    bf16 *WIN, *WOUT, *WFI, *WFO, *H1, *PROJ, *HID, *Y, *H2;
};

__device__ __forceinline__ float bf2f(unsigned u16) { return __uint_as_float(u16 << 16); }
__device__ __forceinline__ float wave_max(float v) {
#pragma unroll
    for (int o = 1; o < 64; o <<= 1) v = fmaxf(v, __shfl_xor(v, o));
    return v;
}
__device__ __forceinline__ float silu_f(float v) { return v * __builtin_amdgcn_rcpf(1.0f + __builtin_amdgcn_exp2f(-LOG2E * v)); }

__device__ __forceinline__ void p0_mod_item(Frame& F, int item) {
    LAS float* sl = (LAS float*)(F.lds);
    LAS float* red = (LAS float*)(F.lds + 32768);
    for (int i = F.tid; i < BATCH * DM; i += NWAVES * 64) { const int b = i >> 10, k = i & 1023; sl[k * 8 + b] = silu_f(F.c[i]); }
    __syncthreads();
    const int col = F.tid & 31, kg = F.tid >> 5, n = item * 32 + col;
    float a0 = 0.f, a1 = 0.f, a2 = 0.f, a3 = 0.f, a4 = 0.f, a5 = 0.f, a6 = 0.f, a7 = 0.f;
#pragma unroll 4
    for (int kk = 0; kk < 64; ++kk) { const int k = kg * 64 + kk; const float w = F.w_ada[(size_t)k * NADA + n];
        const f32x4 s0 = *(LAS f32x4*)(sl + k * 8), s1 = *(LAS f32x4*)(sl + k * 8 + 4);
        a0 += s0[0] * w; a1 += s0[1] * w; a2 += s0[2] * w; a3 += s0[3] * w; a4 += s1[0] * w; a5 += s1[1] * w; a6 += s1[2] * w; a7 += s1[3] * w; }
    red[(kg * 8 + 0) * 32 + col] = a0; red[(kg * 8 + 1) * 32 + col] = a1; red[(kg * 8 + 2) * 32 + col] = a2; red[(kg * 8 + 3) * 32 + col] = a3;
    red[(kg * 8 + 4) * 32 + col] = a4; red[(kg * 8 + 5) * 32 + col] = a5; red[(kg * 8 + 6) * 32 + col] = a6; red[(kg * 8 + 7) * 32 + col] = a7;
    __syncthreads();
    if (F.tid < 256) { const int b = F.tid >> 5, cc = F.tid & 31; float s = 0.f;
#pragma unroll
        for (int g = 0; g < 16; ++g) s += red[(g * 8 + b) * 32 + cc];
        F.MOD[b * NADA + item * 32 + cc] = s + F.b_ada[item * 32 + cc]; }
    __syncthreads();
}
__device__ __forceinline__ void p0_prologue(Frame& F) {
    for (int it = blockIdx.x; it < NADA / 32; it += F.G) p0_mod_item(F, it);
    LAS float* scr = (LAS float*)(F.lds + RING_OFF + F.wave * 16384);
    const int gw = blockIdx.x * NWAVES + F.wave, NGW = F.G * NWAVES;
    constexpr int I_IN = (DM / 64) * (NPROJ / 32), I_OUT = (DM / 64) * (DM / 32), I_FI = (DM / 64) * (NFI / 32), I_FO = (DFF / 64) * (DM / 32);
    constexpr int NITEMS = I_IN + I_OUT + I_FI + I_FO;
    for (int it = gw; it < NITEMS; it += NGW) {
        int r = it;
        if (r < I_IN) { p0_transpose_item(F.w_in, DM, NPROJ, F.WIN, 0, scr, r, F.lane); continue; } r -= I_IN;
        if (r < I_OUT) { p0_transpose_item(F.w_out, DM, DM, F.WOUT, 0, scr, r, F.lane); continue; } r -= I_OUT;
        if (r < I_FI) {
            const int nb = r % (NFI / 32), n0 = 32 * nb; const int isup = n0 >= DFF ? 1 : 0, j0 = n0 - isup * DFF;
            const int dst0 = 256 * (j0 >> 7) + 128 * isup + (j0 & 127);
            p0_transpose_item(F.w_fi, DM, NFI, F.WFI, dst0 - n0, scr, r, F.lane); continue; } r -= I_FI;
        p0_transpose_item(F.w_fo, DFF, DM, F.WFO, 0, scr, r, F.lane);
    }
}
__device__ __forceinline__ void row_stats(const f32x4 (&v)[4], float& mean, float& rstd) {
    float s = 0.f;
#pragma unroll
    for (int j = 0; j < 4; ++j) s += (v[j][0] + v[j][1]) + (v[j][2] + v[j][3]);
    mean = wave_sum(s) * (1.f / DM); float s2 = 0.f;
#pragma unroll
    for (int j = 0; j < 4; ++j) { const f32x4 d = v[j] - mean; s2 += (d[0] * d[0] + d[1] * d[1]) + (d[2] * d[2] + d[3] * d[3]); }
    rstd = 1.f / sqrtf(wave_sum(s2) * (1.f / DM) + LN_EPS);
}
__device__ __forceinline__ void p1_ln_mod(Frame& F) {
    const int gw = blockIdx.x * NWAVES + F.wave, NGW = F.G * NWAVES;
    for (int m = gw; m < M; m += NGW) {
        const float* mod = F.MOD + (size_t)(m >> 12) * NADA;
        const GAS f32x4* xr = (const GAS f32x4*)(F.x + (size_t)m * DM) + F.lane;
        f32x4 v[4];
#pragma unroll
        for (int j = 0; j < 4; ++j) v[j] = xr[64 * j];
        float mean, rstd; row_stats(v, mean, rstd);
        GAS unsigned long long* o8 = (GAS unsigned long long*)(F.H1 + (size_t)m * DM) + F.lane;
#pragma unroll
        for (int j = 0; j < 4; ++j) { const int col = 256 * j + 4 * F.lane;
            const f32x4 sc = *(const f32x4*)(mod + MOD_SC1 + col), sh = *(const f32x4*)(mod + MOD_SH1 + col);
            const f32x4 h = (v[j] - mean) * rstd * (sc + 1.0f) + sh;
            o8[64 * j] = (unsigned long long)pk2(h[0], h[1]) | ((unsigned long long)pk2(h[2], h[3]) << 32); }
    }
}
__device__ __forceinline__ void p7_ln_ln(Frame& F) {
    const int gw = blockIdx.x * NWAVES + F.wave, NGW = F.G * NWAVES;
    for (int m = gw; m < M; m += NGW) {
        const float* mod = F.MOD + (size_t)(m >> 12) * NADA;
        GAS f32x4* zr = (GAS f32x4*)(F.out + (size_t)m * DM) + F.lane;
        f32x4 v[4];
#pragma unroll
        for (int j = 0; j < 4; ++j) v[j] = zr[64 * j];
        float mean, rstd; row_stats(v, mean, rstd);
#pragma unroll
        for (int j = 0; j < 4; ++j) { const int col = 256 * j + 4 * F.lane;
            v[j] = (v[j] - mean) * rstd * *(const f32x4*)(F.ln1_w + col) + *(const f32x4*)(F.ln1_b + col); zr[64 * j] = v[j]; }
        row_stats(v, mean, rstd);
        GAS unsigned long long* o8 = (GAS unsigned long long*)(F.H2 + (size_t)m * DM) + F.lane;
#pragma unroll
        for (int j = 0; j < 4; ++j) { const int col = 256 * j + 4 * F.lane;
            const f32x4 sc = *(const f32x4*)(mod + MOD_SC2 + col), sh = *(const f32x4*)(mod + MOD_SH2 + col);
            const f32x4 h = (v[j] - mean) * rstd * (sc + 1.0f) + sh;
            o8[64 * j] = (unsigned long long)pk2(h[0], h[1]) | ((unsigned long long)pk2(h[2], h[3]) << 32); }
    }
}
__device__ __forceinline__ void p10_ln_final(Frame& F) {
    const int gw = blockIdx.x * NWAVES + F.wave, NGW = F.G * NWAVES;
    for (int m = gw; m < M; m += NGW) {
        GAS f32x4* zr = (GAS f32x4*)(F.out + (size_t)m * DM) + F.lane;
        f32x4 v[4];
#pragma unroll
        for (int j = 0; j < 4; ++j) v[j] = zr[64 * j];
        float mean, rstd; row_stats(v, mean, rstd);
#pragma unroll
        for (int j = 0; j < 4; ++j) { const int col = 256 * j + 4 * F.lane;
            zr[64 * j] = (v[j] - mean) * rstd * *(const f32x4*)(F.ln2_w + col) + *(const f32x4*)(F.ln2_b + col); }
    }
}
__device__ __forceinline__ void p3_kmean(Frame& F) {
    LAS float* red = (LAS float*)F.lds;
    const int d = F.tid & 127, rg = F.tid >> 7;
    for (int it = blockIdx.x; it < BATCH * NH * NBLK; it += F.G) {
        const int j = it & 15, h = (it >> 4) & 3, b = it >> 6;
        const bf16* p = F.PROJ + ((size_t)b * SEQ + j * LBLK + rg * 64) * NPROJ + C_MK + h * HD + d;
        float s = 0.f;
#pragma unroll 8
        for (int r = 0; r < 64; ++r) s += bf2f(p[(size_t)r * NPROJ]);
        red[rg * 128 + d] = s;
        __syncthreads();
        if (F.tid < 128) F.KMEAN[(size_t)it * HD + d] = (red[d] + red[128 + d] + red[256 + d] + red[384 + d]) * (1.f / 256.f);
        __syncthreads();
    }
}
__device__ __forceinline__ void ret_simple_chain(Frame& F, int b, int h) {
    const int tid = F.tid, e = tid & 127, dg = tid >> 7, lane = F.lane;
    LAS float* kl = (LAS float*)F.lds;
    LAS float* ql = kl + 256;
    LAS float* part = ql + 256;
    const float gamma = 1.f - exp2f(-5.f - (float)h);
    float S[32];
#pragma unroll
    for (int i = 0; i < 32; ++i) S[i] = 0.f;
    const bf16* base = F.PROJ + (size_t)b * SEQ * NPROJ + h * HD;
    unsigned nk = 0, nq = 0, nv, ng0 = 0, ng1 = 0;
    if (tid < 128) { nk = base[C_RK + tid]; nq = base[C_RQ + tid]; }
    if (tid < 64) { ng0 = base[C_RG + lane]; ng1 = base[C_RG + lane + 64]; }
    nv = base[C_RV + e];
    for (int t = 0; t < SEQ; ++t) {
        const int pb = t & 1;
        if (tid < 128) { kl[pb * 128 + tid] = bf2f(nk); ql[pb * 128 + tid] = bf2f(nq); }
        const float v = bf2f(nv), g0 = bf2f(ng0), g1 = bf2f(ng1);
        if (t + 1 < SEQ) { const bf16* nb = base + (size_t)(t + 1) * NPROJ;
            if (tid < 128) { nk = nb[C_RK + tid]; nq = nb[C_RQ + tid]; }
            if (tid < 64) { ng0 = nb[C_RG + lane]; ng1 = nb[C_RG + lane + 64]; }
            nv = nb[C_RV + e]; }
        __syncthreads();
        float yp = 0.f;
#pragma unroll
        for (int i = 0; i < 32; i += 4) { const f32x4 k4 = *(LAS f32x4*)(kl + pb * 128 + dg * 32 + i), q4 = *(LAS f32x4*)(ql + pb * 128 + dg * 32 + i);
            S[i] = fmaf(gamma, S[i], k4[0] * v); yp = fmaf(q4[0], S[i], yp);
            S[i + 1] = fmaf(gamma, S[i + 1], k4[1] * v); yp = fmaf(q4[1], S[i + 1], yp);
            S[i + 2] = fmaf(gamma, S[i + 2], k4[2] * v); yp = fmaf(q4[2], S[i + 2], yp);
            S[i + 3] = fmaf(gamma, S[i + 3], k4[3] * v); yp = fmaf(q4[3], S[i + 3], yp); }
        part[(pb * 4 + dg) * 128 + e] = yp;
        __syncthreads();
        if (tid < 64) {
            LAS float* pp = part + pb * 512;
            const float y0 = (pp[lane] + pp[128 + lane]) + (pp[256 + lane] + pp[384 + lane]);
            const float y1 = (pp[lane + 64] + pp[128 + lane + 64]) + (pp[256 + lane + 64] + pp[384 + lane + 64]);
            const float mean = wave_sum(y0 + y1) * (1.f / 128.f); const float d0 = y0 - mean, d1 = y1 - mean;
            const float rstd = 1.f / sqrtf(wave_sum(d0 * d0 + d1 * d1) * (1.f / 128.f) + LN_EPS);
            bf16* yo = F.Y + ((size_t)b * SEQ + t) * DM + h * HD;
            yo[lane] = (bf16)f2bf(silu_f(g0) * d0 * rstd); yo[lane + 64] = (bf16)f2bf(silu_f(g1) * d1 * rstd);
        }
    }
    __syncthreads();
}
__device__ __forceinline__ void moba_simple_wave(Frame& F, int qh, LAS float* wl) {
    const int lane = F.lane;
    const int row = qh >> 2, h = qh & 3, b = row >> 12, t = row & 4095, blk = t >> 8;
    const bf16* P = F.PROJ;
    { const unsigned qq = *(const unsigned*)(P + (size_t)row * NPROJ + C_MQ + h * HD + 2 * lane); wl[2 * lane] = bf2f(qq & 0xffffu); wl[2 * lane + 1] = bf2f(qq >> 16); }
    float gate = -INFINITY;
    if (lane < blk) { const float* km = F.KMEAN + (size_t)((b * NH + h) * NBLK + lane) * HD; float g = 0.f;
        for (int d = 0; d < HD; d += 4) { const f32x4 kv = *(const f32x4*)(km + d); const f32x4 qv = *(LAS f32x4*)(wl + d); g += (kv[0] * qv[0] + kv[1] * qv[1]) + (kv[2] * qv[2] + kv[3] * qv[3]); }
        gate = g; }
    const int nsel = blk < 3 ? blk : 3;
    int s0 = 0, s1 = 0, s2 = 0;
#pragma unroll
    for (int s = 0; s < 3; ++s) {
        float bv = gate; int bi = lane;
#pragma unroll
        for (int o = 1; o < 64; o <<= 1) { const float ov = __shfl_xor(bv, o); const int oi = __shfl_xor(bi, o); if (ov > bv || (ov == bv && oi < bi)) { bv = ov; bi = oi; } }
        if (s == 0) s0 = bi; else if (s == 1) s1 = bi; else s2 = bi;
        if (lane == bi) gate = -INFINITY;
    }
    const float slope2 = exp2f(-2.f * (float)(h + 1)) * LOG2E;
    float sc[4][4]; float mx = -INFINITY;
#pragma unroll
    for (int s = 0; s < 4; ++s) {
        const int bid = (s == 0) ? s0 : (s == 1) ? s1 : (s == 2) ? s2 : blk;
        const bool valid = (s == 3) || (s < nsel);
#pragma unroll
        for (int i = 0; i < 4; ++i) {
            float score = -INFINITY;
            if (valid && (s < 3 || i * 64 <= (t & 255))) {
                const int key = bid * LBLK + i * 64 + lane;
                const bf16* kr = P + ((size_t)b * SEQ + key) * NPROJ + C_MK + h * HD;
                float dot = 0.f;
#pragma unroll 4
                for (int d = 0; d < HD; d += 8) { const v4u kk = *(const v4u*)(kr + d); const f32x4 q0 = *(LAS f32x4*)(wl + d), q1 = *(LAS f32x4*)(wl + d + 4);
                    dot += bf2f(kk[0] & 0xffffu) * q0[0] + bf2f(kk[0] >> 16) * q0[1] + bf2f(kk[1] & 0xffffu) * q0[2] + bf2f(kk[1] >> 16) * q0[3]
                         + bf2f(kk[2] & 0xffffu) * q1[0] + bf2f(kk[2] >> 16) * q1[1] + bf2f(kk[3] & 0xffffu) * q1[2] + bf2f(kk[3] >> 16) * q1[3]; }
                const int dist = t - key;
                if (dist >= 0) score = dot - slope2 * (float)dist;
            }
            sc[s][i] = score; mx = fmaxf(mx, score);
        }
    }
    mx = wave_max(mx);
    float l = 0.f;
#pragma unroll
    for (int s = 0; s < 4; ++s)
#pragma unroll
        for (int i = 0; i < 4; ++i) { sc[s][i] = __builtin_amdgcn_exp2f(sc[s][i] - mx); l += sc[s][i]; }
    l = wave_sum(l);
    float o0 = 0.f, o1 = 0.f;
#pragma unroll
    for (int s = 0; s < 4; ++s) {
        const int bid = (s == 0) ? s0 : (s == 1) ? s1 : (s == 2) ? s2 : blk;
        const bool valid = (s == 3) || (s < nsel);
#pragma unroll
        for (int i = 0; i < 4; ++i) {
            if (valid && (s < 3 || i * 64 <= (t & 255))) {
                wl[128 + lane] = sc[s][i];
                const bf16* vr = P + ((size_t)b * SEQ + bid * LBLK + i * 64) * NPROJ + C_MV + h * HD + 2 * lane;
#pragma unroll 8
                for (int kk = 0; kk < 64; ++kk) { const float p = wl[128 + kk]; const unsigned vv = *(const unsigned*)(vr + (size_t)kk * NPROJ);
                    o0 = fmaf(p, bf2f(vv & 0xffffu), o0); o1 = fmaf(p, bf2f(vv >> 16), o1); }
            }
        }
    }
    const float rl = 1.f / l;
    *(unsigned*)(F.Y + (size_t)row * DM + 512 + h * HD + 2 * lane) = pk2(o0 * rl, o1 * rl);
}
__device__ __forceinline__ void p5_mixers_simple(Frame& F) {
    if (blockIdx.x < BATCH * NH) ret_simple_chain(F, blockIdx.x >> 2, blockIdx.x & 3);
    LAS float* wl = (LAS float*)(F.lds + 8192) + F.wave * 192;
    const int gw = blockIdx.x * NWAVES + F.wave, NGW = F.G * NWAVES;
    for (int qh = gw; qh < M * NH; qh += NGW) moba_simple_wave(F, qh, wl);
}


namespace moba {
constexpr int NW = 8, QBLK = 32, KVBLK = 64, QB = NW * QBLK, D = 128;
constexpr int LDQ = NPROJ;
constexpr int SHM_V = KVBLK * D * 2, SHM_K = KVBLK * D * 2;
constexpr int LDS_NEED = 2 * SHM_V + 2 * SHM_K + NW * 64 * 4;
constexpr float THR2 = 8.f * 1.4426950408889634f;
typedef short bf16x8 __attribute__((ext_vector_type(8)));
typedef short s16x4 __attribute__((ext_vector_type(4)));
typedef float f32x16 __attribute__((ext_vector_type(16)));
typedef unsigned u32x4 __attribute__((ext_vector_type(4)));
#define KSWZ(row, colB) ((row) * 256 + ((colB) ^ (((row) & 7) << 4)))
#define SBAR() __builtin_amdgcn_sched_barrier(0)
__device__ __forceinline__ int v_st(int k, int c) { const int kk = (k & ~0xC) | ((k & 4) << 1) | ((k & 8) >> 1); return ((kk >> 3) * 4 + (c >> 5)) * 512 + ((kk & 7) * 32 + (c & 31)) * 2; }
__device__ __forceinline__ int v_rd_base(int lane) { return ((lane & 3) << 3) | (((lane >> 2) & 3) << 6) | (((lane >> 4) & 1) << 5) | (((lane >> 5) & 1) << 8); }
constexpr int v_rd_off(int d0, int ks, int half) { return d0 * 512 + ks * 4096 + half * 2048; }
__device__ __forceinline__ int crow(int r, int hi) { return (r & 3) + 8 * (r >> 2) + 4 * hi; }
__device__ __forceinline__ unsigned cvtpk(float lo, float hi) { unsigned r; asm volatile("v_cvt_pk_bf16_f32 %0, %1, %2" : "=v"(r) : "v"(lo), "v"(hi)); return r; }
__device__ __forceinline__ bf16x8 load8(const bf16* p) { return *reinterpret_cast<const bf16x8*>(p); }
__device__ __forceinline__ void mask_tile(f32x16& p0, f32x16& p1, int dq) {
    const float NEG = -__builtin_inff();
#pragma unroll
    for (int r = 0; r < 16; ++r) { const int c = (r & 3) + 8 * (r >> 2);
        if (dq - c < 0) p0[r] = NEG;
        if (dq - c - 32 < 0) p1[r] = NEG; }
}
__device__ __forceinline__ void partialSM(f32x16& p0, f32x16& p1, float slope2, float base, bool sel, float& m_reg, float& mn, float& alpha) {
    const float NEG = -__builtin_inff();
#pragma unroll
    for (int r = 0; r < 16; ++r) { const int c = (r & 3) + 8 * (r >> 2); p0[r] = fmaf(slope2, (float)c, p0[r]); p1[r] = fmaf(slope2, (float)(c + 32), p1[r]); }
    float pmax = p0[0];
#pragma unroll
    for (int r = 1; r < 16; ++r) pmax = fmaxf(pmax, p0[r]);
#pragma unroll
    for (int r = 0; r < 16; ++r) pmax = fmaxf(pmax, p1[r]);
    pmax = sel ? pmax + base : NEG;
    { auto rr = __builtin_amdgcn_permlane32_swap(__float_as_uint(pmax), __float_as_uint(pmax), false, false);
      pmax = fmaxf(__uint_as_float(rr[0]), __uint_as_float(rr[1])); }
    if (__builtin_expect(__all(pmax - m_reg <= THR2), 1)) { mn = m_reg; alpha = 1.f; }
    else { mn = fmaxf(m_reg, pmax); alpha = __builtin_amdgcn_exp2f(m_reg - mn); m_reg = mn; }
    const float sh = sel ? base - mn : NEG;
#pragma unroll
    for (int r = 0; r < 16; ++r) p0[r] += sh;
#pragma unroll
    for (int r = 0; r < 16; ++r) p1[r] += sh;
#pragma unroll
    for (int r = 0; r < 16; ++r) p0[r] = __builtin_amdgcn_exp2f(p0[r]);
}
__device__ __forceinline__ void finishSM(f32x16& p0, f32x16& p1, float alpha, float& l_reg, bf16x8& pa0, bf16x8& pa1, bf16x8& pa2, bf16x8& pa3) {
#pragma unroll
    for (int r = 0; r < 16; ++r) p1[r] = __builtin_amdgcn_exp2f(p1[r]);
    float ps = 0;
#pragma unroll
    for (int r = 0; r < 16; ++r) ps += p0[r];
#pragma unroll
    for (int r = 0; r < 16; ++r) ps += p1[r];
    { auto rr = __builtin_amdgcn_permlane32_swap(__float_as_uint(ps), __float_as_uint(ps), false, false);
      ps = __uint_as_float(rr[0]) + __uint_as_float(rr[1]); }
    l_reg = l_reg * alpha + ps;
#define PK4(P, B_, OUT) do { unsigned a0 = cvtpk(P[B_+0], P[B_+1]), a1 = cvtpk(P[B_+2], P[B_+3]);                          \
        unsigned b0 = cvtpk(P[B_+4], P[B_+5]), b1 = cvtpk(P[B_+6], P[B_+7]);                                             \
        auto r0 = __builtin_amdgcn_permlane32_swap(a0, b0, false, false); auto r1 = __builtin_amdgcn_permlane32_swap(a1, b1, false, false); \
        u32x4 w = {r0[0], r1[0], r0[1], r1[1]}; OUT = *reinterpret_cast<bf16x8*>(&w); } while (0)
    PK4(p0, 0, pa0); PK4(p0, 8, pa1); PK4(p1, 0, pa2); PK4(p1, 8, pa3);
#undef PK4
}
template <int KB>
__device__ __forceinline__ void qkt(f32x16& p0, f32x16& p1, const char* K_lds, int r32, int hi, const bf16x8* qr) {
    p0 = f32x16{}; p1 = f32x16{};
    const char* kb[4];
#pragma unroll
    for (int dd = 0; dd < 4; ++dd) kb[dd] = K_lds + KB * SHM_K + KSWZ(r32, (dd * 16 + hi * 8) * 2);
#pragma unroll
    for (int d0 = 0; d0 < 8; ++d0) { const char* a = kb[d0 & 3] + (d0 >> 2) * 128;
        bf16x8 b0 = *reinterpret_cast<const bf16x8*>(a);
        bf16x8 b1 = *reinterpret_cast<const bf16x8*>(a + 32 * 256);
        p0 = __builtin_amdgcn_mfma_f32_32x32x16_bf16(b0, qr[d0], p0, 0, 0, 0);
        p1 = __builtin_amdgcn_mfma_f32_32x32x16_bf16(b1, qr[d0], p1, 0, 0, 0); }
}
template <int VB>
__device__ __forceinline__ void pv_tile(f32x16* o, int vb0, bf16x8 pa0, bf16x8 pa1, bf16x8 pa2, bf16x8 pa3) {
#define TRRD(dst, off) asm volatile("ds_read_b64_tr_b16 %0, %1 offset:%2" : "=&v"(dst) : "v"(vb0), "i"(off) : "memory")
#define PV_D0(d0) do { s16x4 l0, l1, l2, l3, h0, h1, h2, h3; constexpr int b_ = VB * SHM_V + v_rd_off(d0, 0, 0); \
        TRRD(l0, b_); TRRD(h0, b_ + 2048); TRRD(l1, b_ + 4096); TRRD(h1, b_ + 6144); TRRD(l2, b_ + 8192); TRRD(h2, b_ + 10240); TRRD(l3, b_ + 12288); TRRD(h3, b_ + 14336); \
        asm volatile("s_waitcnt lgkmcnt(0)" ::: "memory"); SBAR();   \
        o[d0] = __builtin_amdgcn_mfma_f32_32x32x16_bf16(pa0, (bf16x8){l0[0], l0[1], l0[2], l0[3], h0[0], h0[1], h0[2], h0[3]}, o[d0], 0, 0, 0);   \
        o[d0] = __builtin_amdgcn_mfma_f32_32x32x16_bf16(pa1, (bf16x8){l1[0], l1[1], l1[2], l1[3], h1[0], h1[1], h1[2], h1[3]}, o[d0], 0, 0, 0);   \
        o[d0] = __builtin_amdgcn_mfma_f32_32x32x16_bf16(pa2, (bf16x8){l2[0], l2[1], l2[2], l2[3], h2[0], h2[1], h2[2], h2[3]}, o[d0], 0, 0, 0);   \
        o[d0] = __builtin_amdgcn_mfma_f32_32x32x16_bf16(pa3, (bf16x8){l3[0], l3[1], l3[2], l3[3], h3[0], h3[1], h3[2], h3[3]}, o[d0], 0, 0, 0); } while (0)
    PV_D0(0); PV_D0(1); PV_D0(2); PV_D0(3);
#undef PV_D0
#undef TRRD
}
struct BlockRef { const bf16* Q; const bf16* K; const bf16* V; bf16* O; const float* KM; int P0; float slope2; };
struct Seam { bf16x8 qr[8]; bf16x8 st_v0, st_v1, st_k0, st_k1; };
#define ROW(p, k0, rr) ((p) + (size_t)((k0) + (rr)) * LDQ + sc)
#define VMW() asm volatile("s_waitcnt vmcnt(0)" ::: "memory")
#define VMWN(n) asm volatile("s_waitcnt vmcnt(%0)" :: "i"(n) : "memory")
#define SLOAD_H(Kp, Vp, k0) do { S.st_v0 = load8(ROW(Vp, k0, sr)); S.st_v1 = load8(ROW(Vp, k0, 32 + sr));              \
                         S.st_k0 = load8(ROW(Kp, k0, sr)); S.st_k1 = load8(ROW(Kp, k0, 32 + sr)); } while (0)
#define SWRITE_HK(bf) do { *(bf16x8*)(K_lds + (bf) * SHM_K + kws) = S.st_k0; *(bf16x8*)(K_lds + (bf) * SHM_K + kws + 32 * 256) = S.st_k1; } while (0)
#define SWRITE_HV(bf) do { *(bf16x8*)(V_lds + (bf) * SHM_V + vst0) = S.st_v0; *(bf16x8*)(V_lds + (bf) * SHM_V + vst1) = S.st_v1; } while (0)
#define SWRITE_H(bf) do { SWRITE_HV(bf); SWRITE_HK(bf); } while (0)
__device__ __forceinline__ void prime(const BlockRef& cur, char* lds, Seam& S) {
    const int tid = threadIdx.x, wid = __builtin_amdgcn_readfirstlane(tid >> 6), lane = tid & 63, r32 = lane & 31, hi = lane >> 5;
    const int sr = tid >> 4, sc = (tid & 15) * 8, kws = KSWZ(sr, sc * 2); char* K_lds = lds + 2 * SHM_V;
#pragma unroll
    for (int d0 = 0; d0 < 8; ++d0) S.qr[d0] = load8(cur.Q + (size_t)(wid * QBLK + r32) * LDQ + d0 * 16 + hi * 8);
    SLOAD_H(cur.K, cur.V, 0); VMW(); SWRITE_HK(0);
    __syncthreads();
}
__device__ __forceinline__ unsigned select_blocks(const bf16x8* qr, const float* km, int blk, int hi) {
    float v0 = -__builtin_inff(), v1 = v0, v2 = v0; int i0 = -1, i1 = -1, i2 = -1;
    for (int j = 0; j < blk; ++j) {
        const float* kj = km + j * D + hi * 8; float g = 0.f;
#pragma unroll
        for (int d0 = 0; d0 < 8; ++d0) { const f32x4 a = *(const f32x4*)(kj + d0 * 16), b = *(const f32x4*)(kj + d0 * 16 + 4); const bf16x8 q = qr[d0];
            g += (bf2f((unsigned short)q[0]) * a[0] + bf2f((unsigned short)q[1]) * a[1]) + (bf2f((unsigned short)q[2]) * a[2] + bf2f((unsigned short)q[3]) * a[3])
               + (bf2f((unsigned short)q[4]) * b[0] + bf2f((unsigned short)q[5]) * b[1]) + (bf2f((unsigned short)q[6]) * b[2] + bf2f((unsigned short)q[7]) * b[3]); }
        g += __shfl_xor(g, 32);
        if (g > v0) { v2 = v1; i2 = i1; v1 = v0; i1 = i0; v0 = g; i0 = j; }
        else if (g > v1) { v2 = v1; i2 = i1; v1 = g; i1 = j; }
        else if (g > v2) { v2 = g; i2 = j; }
    }
    unsigned m = 1u << blk;
    if (i0 >= 0) m |= 1u << i0; if (i1 >= 0) m |= 1u << i1; if (i2 >= 0) m |= 1u << i2;
    return m;
}
__device__ __forceinline__ void block(const BlockRef& cur, const BlockRef& nxt, char* lds, Seam& S) {
    const int tid = threadIdx.x, wid = __builtin_amdgcn_readfirstlane(tid >> 6), lane = tid & 63, r32 = lane & 31, hi = lane >> 5;
    const int blk = cur.P0 >> 8;
    const int NT = 4 * blk + 4;
    const int qlo = cur.P0 + wid * QBLK, qm = qlo + r32 - 4 * hi;
    const float slope2 = cur.slope2;
    const unsigned selm = select_blocks(S.qr, cur.KM, blk, hi);
    char* V_lds = lds; char* K_lds = lds + 2 * SHM_V;
    float* ws = (float*)(lds + 2 * SHM_V + 2 * SHM_K) + wid * 64; float* li_l = ws, * al_l = ws + 32;
    float m_reg = -1e30f, l_reg = 0; f32x16 o[4] = {};
    const int sr = tid >> 4, sc = (tid & 15) * 8, vst0 = v_st(sr, sc), vst1 = v_st(32 + sr, sc), kws = KSWZ(sr, sc * 2);
    const int vb0 = (int)(uintptr_t)V_lds + v_rd_base(lane);
    const bf16* Kh = cur.K; const bf16* Vh = cur.V;
#define RESC(a) do { if (__any((a) < 1.f)) { if (hi == 0) al_l[r32] = (a); asm volatile("s_waitcnt lgkmcnt(0)" ::: "memory");              \
                     for (int d_ = 0; d_ < 4; ++d_) for (int r = 0; r < 16; ++r) o[d_][r] *= al_l[crow(r, hi)]; } } while (0)
#define KBASE(t) ((t) * KVBLK)
#define BASE(t) (slope2 * (float)(KBASE(t) - qm))
#define SEL(t) (((selm >> ((t) >> 2)) & 1u) != 0u)
#define MASKT(P0_, P1_, t) do { const int kb_ = KBASE(t); if (kb_ + KVBLK - 1 > qlo) mask_tile(P0_, P1_, qm - kb_); } while (0)
    constexpr int NQL = 8;
#define SEAM_K0() do { VMWN(NQL); SWRITE_HK(0); SBAR(); } while (0)
    f32x16 pA0, pA1, pB0, pB1; float mnA, mnB, alA, alB; bf16x8 pa0, pa1, pa2, pa3;
    SWRITE_HV(0); SBAR();
    if (NT > 1) { SLOAD_H(Kh, Vh, KBASE(1)); }
    SBAR(); qkt<0>(pA0, pA1, K_lds, r32, hi, S.qr);
    MASKT(pA0, pA1, 0); partialSM(pA0, pA1, slope2, BASE(0), SEL(0), m_reg, mnA, alA);
    if (NT > 1) { VMW(); SWRITE_H(1); }
    __syncthreads();
#define HALF_STEP(PX0, PX1, mnX, alX, PY0, PY1, alY, t, KB, VB, SB) do {                                                      \
        SBAR(); qkt<KB>(PX0, PX1, K_lds, r32, hi, S.qr);                                             \
        finishSM(PY0, PY1, alY, l_reg, pa0, pa1, pa2, pa3); SBAR();                                                           \
        if ((t) + 1 < NT) { SLOAD_H(Kh, Vh, KBASE((t) + 1)); SBAR(); }                                               \
        pv_tile<VB>(o, vb0, pa0, pa1, pa2, pa3); MASKT(PX0, PX1, (t)); partialSM(PX0, PX1, slope2, BASE(t), SEL(t), m_reg, mnX, alX);                                        \
        __syncthreads();                                                                                                      \
        if ((t) + 1 < NT) { VMW(); SWRITE_H(SB); }                                                                          \
        RESC(alX); __syncthreads(); } while (0)
    for (int t = 1; t + 1 < NT; t += 2) {
        HALF_STEP(pB0, pB1, mnB, alB, pA0, pA1, alA, t, 1, 0, 0);
        HALF_STEP(pA0, pA1, mnA, alA, pB0, pB1, alB, t + 1, 0, 1, 1);
    }
    { SBAR(); qkt<1>(pB0, pB1, K_lds, r32, hi, S.qr); SBAR(); }
    SLOAD_H(nxt.K, nxt.V, 0); SBAR();
#pragma unroll
    for (int d0 = 0; d0 < 8; ++d0) S.qr[d0] = load8(nxt.Q + (size_t)(wid * QBLK + r32) * LDQ + d0 * 16 + hi * 8);
    SBAR();
    finishSM(pA0, pA1, alA, l_reg, pa0, pa1, pa2, pa3); SBAR();
    pv_tile<0>(o, vb0, pa0, pa1, pa2, pa3);
    { MASKT(pB0, pB1, NT - 1); partialSM(pB0, pB1, slope2, BASE(NT - 1), SEL(NT - 1), m_reg, mnB, alB); __syncthreads(); RESC(alB);
      finishSM(pB0, pB1, alB, l_reg, pa0, pa1, pa2, pa3); SBAR(); pv_tile<1>(o, vb0, pa0, pa1, pa2, pa3); }
    SBAR(); SEAM_K0();
    if (hi == 0) li_l[r32] = l_reg; asm volatile("s_waitcnt lgkmcnt(0)" ::: "memory");
    float rli[16];
#pragma unroll
    for (int r = 0; r < 16; ++r) rli[r] = __builtin_amdgcn_rcpf(li_l[crow(r, hi)]);
    bf16* Ow = cur.O + (size_t)(wid * QBLK) * DM;
#pragma unroll
    for (int r = 0; r < 16; ++r) { const int orow = crow(r, hi);
#pragma unroll
        for (int d0 = 0; d0 < 4; ++d0) { const float v = o[d0][r] * rli[r];
            const float vn = __shfl_xor(v, 1);
            if ((r32 & 1) == 0) *(unsigned*)(Ow + (size_t)orow * DM + d0 * 32 + r32) = cvtpk(v, vn); } }
    __syncthreads();
#undef RESC
#undef KBASE
#undef BASE
#undef SEL
#undef MASKT
#undef SEAM_K0
#undef HALF_STEP
}
#undef ROW
#undef VMW
#undef VMWN
#undef SLOAD_H
#undef SWRITE_HK
#undef SWRITE_HV
#undef SWRITE_H
#undef KSWZ
#undef SBAR
}
__device__ __forceinline__ moba::BlockRef moba_ref(Frame& F, int L, int pass) {
    const int bh = L >> 3, s = L & 7, b = bh >> 2, h = bh & 3, qb = pass ? 15 - s : s;
    moba::BlockRef r;
    r.Q = F.PROJ + ((size_t)b * SEQ + qb * 256) * NPROJ + C_MQ + h * HD;
    r.K = F.PROJ + (size_t)b * SEQ * NPROJ + C_MK + h * HD;
    r.V = F.PROJ + (size_t)b * SEQ * NPROJ + C_MV + h * HD;
    r.O = F.Y + ((size_t)b * SEQ + qb * 256) * DM + 512 + h * HD;
    r.KM = F.KMEAN + (size_t)bh * NBLK * HD;
    r.P0 = qb * 256;
    r.slope2 = exp2f(-2.f * (float)(h + 1)) * LOG2E;
    return r;
}
__device__ __forceinline__ void p5_moba(Frame& F, char* lds) {
    const int G = F.G, bx = blockIdx.x, vcu = (G % 8 == 0) ? (bx % 8) * (G / 8) + bx / 8 : bx;
    int L = vcu; if (L >= 256) return;
    int pass = 0;
    moba::BlockRef cur = moba_ref(F, L, 0);
    moba::Seam S;
    moba::prime(cur, lds, S);
    for (;;) {
        const bool more_pass = pass == 0, more_item = L + G < 256, last = !more_pass && !more_item;
        int passn = pass + 1, Ln = L;
        if (!more_pass) { passn = 0; Ln = more_item ? L + G : L; }
        const moba::BlockRef nxt = last ? cur : moba_ref(F, Ln, passn);
        moba::block(cur, nxt, lds, S);
        if (last) break;
        cur = nxt; pass = passn; L = Ln;
    }
}

namespace ret {
typedef short bf16x8 __attribute__((ext_vector_type(8)));
typedef short v4i16 __attribute__((ext_vector_type(4)));
typedef float f32x16 __attribute__((ext_vector_type(16)));
typedef unsigned u32x4 __attribute__((ext_vector_type(4)));
constexpr int RS = 320;
constexpr int TILE_B = 128 * RS;
constexpr int YLD = 132;
__device__ __forceinline__ int crow(int r, int hi) { return (r & 3) + 8 * (r >> 2) + 4 * hi; }
__device__ __forceinline__ unsigned cvtpk(float lo, float hi) { unsigned r; asm volatile("v_cvt_pk_bf16_f32 %0, %1, %2" : "=v"(r) : "v"(lo), "v"(hi)); return r; }
__device__ __forceinline__ bf16x8 trfrag(LAS const unsigned char* tile, int s0, int rstep, int c0, int lane) {
    LAS const unsigned char* a = tile + (s0 + ((lane & 15) >> 2)) * RS + (c0 + 16 * ((lane >> 4) & 1) + 4 * (lane & 3)) * 2;
    const v4i16 lo = __builtin_amdgcn_ds_read_tr16_b64_v4i16((LAS v4i16*)a);
    const v4i16 hi = __builtin_amdgcn_ds_read_tr16_b64_v4i16((LAS v4i16*)(a + rstep * RS));
    return (bf16x8){lo[0], lo[1], lo[2], lo[3], hi[0], hi[1], hi[2], hi[3]};
}
template <bool SCALE>
__device__ __forceinline__ void stage_tile(LAS unsigned char* dst, const bf16* src, int tid, float lg2g) {
#pragma unroll
    for (int i = 0; i < 4; ++i) { const int p = tid + 512 * i, row = p >> 4, pc = p & 15;
        u32x4 v = *(const u32x4*)(src + (size_t)row * NPROJ + 8 * pc);
        if (SCALE) { const float w = __builtin_amdgcn_exp2f(lg2g * (float)(127 - row));
#pragma unroll
            for (int j = 0; j < 4; ++j) v[j] = cvtpk(bf2f(v[j] & 0xffffu) * w, bf2f(v[j] >> 16) * w); }
        *(LAS u32x4*)(dst + row * RS + 16 * pc) = v; }
}
__device__ __forceinline__ void r1_item(Frame& F, int item, float* KVT) {
    const int tid = F.tid, lane = F.lane, w = F.wave, n = item & 31, bh = item >> 5, h = bh & 3, b = bh >> 2;
    const float lg2g = log2f(1.f - exp2f(-5.f - (float)h));
    LAS unsigned char* Kt = F.lds; LAS unsigned char* Vt = F.lds + TILE_B;
    const bf16* rowp = F.PROJ + ((size_t)b * SEQ + n * 128) * NPROJ + h * HD;
    stage_tile<true>(Kt, rowp + C_RK, tid, lg2g);
    stage_tile<false>(Vt, rowp + C_RV, tid, 0.f);
    __syncthreads();
    const int e0 = 32 * (w >> 1), d0 = 64 * (w & 1), half = lane >> 5;
    f32x16 acc0 = {}, acc1 = {};
#pragma unroll
    for (int ks = 0; ks < 8; ++ks) {
        const bf16x8 a = trfrag(Vt, 16 * ks + 8 * half, 4, e0, lane);
        const bf16x8 b0 = trfrag(Kt, 16 * ks + 8 * half, 4, d0, lane), b1 = trfrag(Kt, 16 * ks + 8 * half, 4, d0 + 32, lane);
        acc0 = __builtin_amdgcn_mfma_f32_32x32x16_bf16(a, b0, acc0, 0, 0, 0);
        acc1 = __builtin_amdgcn_mfma_f32_32x32x16_bf16(a, b1, acc1, 0, 0, 0);
    }
    float* o = KVT + (size_t)item * 16384 + d0 + (lane & 31);
#pragma unroll
    for (int r = 0; r < 16; ++r) { const int e = e0 + crow(r, half); o[e * 128] = acc0[r]; o[e * 128 + 32] = acc1[r]; }
    __syncthreads();
}
__device__ __forceinline__ void r2_scan(Frame& F, const float* KVT, bf16* ST) {
    const int gt = blockIdx.x * (NWAVES * 64) + F.tid, NT = F.G * NWAVES * 64;
    for (int idx = gt; idx < BATCH * NH * 16384; idx += NT) {
        const int bh = idx >> 14, ed = idx & 16383, h = bh & 3;
        const float gc = exp2f(128.f * log2f(1.f - exp2f(-5.f - (float)h)));
        const float* kp = KVT + (size_t)bh * 32 * 16384 + ed; bf16* sp = ST + (size_t)bh * 32 * 16384 + ed;
        float s = 0.f;
#pragma unroll 8
        for (int n = 0; n < 32; ++n) { const float kv = kp[(size_t)n * 16384]; sp[(size_t)n * 16384] = (bf16)f2bf(s); s = fmaf(gc, s, kv); }
    }
}
__device__ __forceinline__ void r3_item(Frame& F, int item, const bf16* ST) {
    const int tid = F.tid, lane = F.lane, w = F.wave, n = item & 31, bh = item >> 5, h = bh & 3, b = bh >> 2;
    const int cl = lane & 31, half = lane >> 5;
    const float lg2g = log2f(1.f - exp2f(-5.f - (float)h));
    LAS unsigned char* Vt = F.lds; LAS float* Yb = (LAS float*)(F.lds + TILE_B);
    const size_t row0 = (size_t)b * SEQ + n * 128;
    const bf16* rowp = F.PROJ + row0 * NPROJ + h * HD;
    stage_tile<false>(Vt, rowp + C_RV, tid, 0.f);
    const int ct = (w < 4) ? w : 7 - w, eh = w >> 2, e0 = 64 * eh;
    bf16x8 qf[8];
#pragma unroll
    for (int ks = 0; ks < 8; ++ks) qf[ks] = *(const bf16x8*)(rowp + (size_t)(32 * ct + cl) * NPROJ + C_RQ + 16 * ks + 8 * half);
    float fdec[16], qd[16];
#pragma unroll
    for (int r = 0; r < 16; ++r) { fdec[r] = __builtin_amdgcn_exp2f(lg2g * (float)(cl - crow(r, half))); qd[r] = __builtin_amdgcn_exp2f(lg2g * (float)(32 * ct + crow(r, half) + 1)); }
    f32x16 intra0 = {}, intra1 = {}, inter0 = {}, inter1 = {};
    const bf16* stp = ST + (size_t)item * 16384 + (size_t)(e0 + cl) * 128 + 8 * half;
#pragma unroll
    for (int ks = 0; ks < 8; ++ks) {
        const bf16x8 s0 = *(const bf16x8*)(stp + 16 * ks), s1 = *(const bf16x8*)(stp + 32 * 128 + 16 * ks);
        inter0 = __builtin_amdgcn_mfma_f32_32x32x16_bf16(qf[ks], s0, inter0, 0, 0, 0);
        inter1 = __builtin_amdgcn_mfma_f32_32x32x16_bf16(qf[ks], s1, inter1, 0, 0, 0);
    }
    __syncthreads();
    for (int st = 0; st <= ct; ++st) {
        f32x16 sT = {};
        const bf16* kp = rowp + (size_t)(32 * st + cl) * NPROJ + C_RK + 8 * half;
#pragma unroll
        for (int ks = 0; ks < 8; ++ks) { const bf16x8 kf = *(const bf16x8*)(kp + 16 * ks); sT = __builtin_amdgcn_mfma_f32_32x32x16_bf16(kf, qf[ks], sT, 0, 0, 0); }
        const float sc = __builtin_amdgcn_exp2f(lg2g * (float)(32 * (ct - st)));
        const bool diag = (st == ct);
#pragma unroll
        for (int r = 0; r < 16; ++r) { float v = sT[r] * (fdec[r] * sc); if (diag && cl < crow(r, half)) v = 0.f; sT[r] = v; }
#pragma unroll
        for (int k2 = 0; k2 < 2; ++k2) {
            u32x4 pw; pw[0] = cvtpk(sT[8 * k2 + 0], sT[8 * k2 + 1]); pw[1] = cvtpk(sT[8 * k2 + 2], sT[8 * k2 + 3]); pw[2] = cvtpk(sT[8 * k2 + 4], sT[8 * k2 + 5]); pw[3] = cvtpk(sT[8 * k2 + 6], sT[8 * k2 + 7]);
            const bf16x8 pa = __builtin_bit_cast(bf16x8, pw);
            const bf16x8 v0 = trfrag(Vt, 32 * st + 16 * k2 + 4 * half, 8, e0, lane), v1 = trfrag(Vt, 32 * st + 16 * k2 + 4 * half, 8, e0 + 32, lane);
            intra0 = __builtin_amdgcn_mfma_f32_32x32x16_bf16(pa, v0, intra0, 0, 0, 0);
            intra1 = __builtin_amdgcn_mfma_f32_32x32x16_bf16(pa, v1, intra1, 0, 0, 0);
        }
    }
#pragma unroll
    for (int r = 0; r < 16; ++r) { LAS float* yr = Yb + (32 * ct + crow(r, half)) * YLD + e0 + cl;
        yr[0] = intra0[r] + qd[r] * inter0[r]; yr[32] = intra1[r] + qd[r] * inter1[r]; }
    __syncthreads();
#pragma unroll 4
    for (int i = 0; i < 16; ++i) { const int c = 16 * w + i;
        const float y0 = Yb[c * YLD + 2 * lane], y1 = Yb[c * YLD + 2 * lane + 1];
        const unsigned gg = *(const unsigned*)(rowp + (size_t)c * NPROJ + C_RG + 2 * lane);
        const float mean = wave_sum(y0 + y1) * (1.f / 128.f); const float d0 = y0 - mean, d1 = y1 - mean;
        const float rstd = 1.f / sqrtf(wave_sum(d0 * d0 + d1 * d1) * (1.f / 128.f) + LN_EPS);
        *(unsigned*)(F.Y + (row0 + c) * DM + h * HD + 2 * lane) = pk2(silu_f(bf2f(gg & 0xffffu)) * d0 * rstd, silu_f(bf2f(gg >> 16)) * d1 * rstd); }
    __syncthreads();
}
}
constexpr int N_PHASES = 11;
#ifndef MK_N_LAUNCHES
#define MK_N_LAUNCHES 1
#endif
constexpr int N_LAUNCHES = MK_N_LAUNCHES;
struct Args { const float* in[12]; float* out; unsigned char* ws; int ph_lo, ph_hi; };
__global__ void __launch_bounds__(NWAVES * 64, 2) fwd_kernel(Args args) {
    extern __shared__ __attribute__((aligned(16))) unsigned char lds[];
    Frame F;
    F.lds = (LAS unsigned char*)lds;
    F.MISC = (volatile LAS unsigned*)(F.lds + MISC_OFF);
    F.tid = threadIdx.x; F.lane = F.tid & 63; F.wave = __builtin_amdgcn_readfirstlane(F.tid >> 6); F.G = gridDim.x;
    unsigned char* ws = args.ws;
    F.ctl = (gu32*)(ws + WS_CTL);
    F.x = args.in[0]; F.c = args.in[1]; F.w_ada = args.in[2]; F.b_ada = args.in[3]; F.w_in = args.in[4]; F.w_out = args.in[5];
    F.ln1_w = args.in[6]; F.ln1_b = args.in[7]; F.w_fi = args.in[8]; F.w_fo = args.in[9]; F.ln2_w = args.in[10]; F.ln2_b = args.in[11];
    F.out = args.out;
    F.MOD = (float*)(ws + WS_MOD); F.KMEAN = (float*)(ws + WS_KMEAN);
    F.WIN = (bf16*)(ws + WS_WIN); F.WOUT = (bf16*)(ws + WS_WOUT); F.WFI = (bf16*)(ws + WS_WFI); F.WFO = (bf16*)(ws + WS_WFO);
    F.H1 = (bf16*)(ws + WS_H1); F.PROJ = (bf16*)(ws + WS_PROJ); F.HID = (bf16*)(ws + WS_HID); F.Y = (bf16*)(ws + WS_Y); F.H2 = (bf16*)(ws + WS_H2);
    for (int u = F.tid; u < (LDS_BYTES - LDSCTL_OFF) / 4; u += NWAVES * 64) ((LAS unsigned*)(F.lds + LDSCTL_OFF))[u] = 0u;
    __syncthreads();
    XcdBarrier bar; bar.bar = (unsigned*)(F.ctl + CW_BAR); bar.x = 0; bar.st = nullptr;
    if (N_LAUNCHES == 1) bar = xcd_barrier_post((unsigned*)(F.ctl + CW_BAR), F.MISC + 8);
#define GRID_BAR() do { if (N_LAUNCHES == 1) xcd_barrier(bar); } while (0)
    const int lo = args.ph_lo, hi = args.ph_hi;
#define IN(k) (lo <= (k) && (k) < hi)
#define BOTH(k) (IN(k) && IN((k) + 1))
    if (IN(0)) { p0_prologue(F); if (BOTH(0)) GRID_BAR(); }
    if (IN(1)) { p1_ln_mod(F); if (BOTH(1)) GRID_BAR(); }
    if (IN(2)) {
        pg8::Gemm g{F.H1, F.WIN, M, NPROJ, DM}; pg8::StaticOrder S; S.init(M, NPROJ, F.G, (int)blockIdx.x);
        pg8::EpiProj E{F.PROJ, NPROJ, RSQD, RSQD * LOG2E};
        pg8::gemm_phase<pg8::EpiProj, pg8::StaticOrder, true, true>(F.lds + RING_OFF, g, S, E);
        if (BOTH(2)) GRID_BAR();
    }
    float* KVT = (float*)(ws + WS_H1); bf16* ST = (bf16*)(ws + WS_H2);
    if (IN(3)) { p3_kmean(F); for (int it = blockIdx.x; it < BATCH * NH * 32; it += F.G) ret::r1_item(F, it, KVT); if (BOTH(3)) GRID_BAR(); }
    if (IN(4)) { ret::r2_scan(F, KVT, ST); if (BOTH(4)) GRID_BAR(); }
    if (IN(5)) {
        p5_moba(F, (char*)lds);
        for (int it = blockIdx.x; it < BATCH * NH * 32; it += F.G) ret::r3_item(F, it, ST);
        if (BOTH(5)) GRID_BAR(); }
    if (IN(6)) {
        pg8::Gemm g{F.Y, F.WOUT, M, DM, DM}; pg8::StaticOrder S; S.init(M, DM, F.G, (int)blockIdx.x);
        pg8::EpiRes E{F.x, F.out, F.MOD + MOD_G1, NADA, ALPHA};
        pg8::gemm_phase<pg8::EpiRes, pg8::StaticOrder, true, true>(F.lds + RING_OFF, g, S, E);
        if (BOTH(6)) GRID_BAR();
    }
    if (IN(7)) { p7_ln_ln(F); if (BOTH(7)) GRID_BAR(); }
    if (IN(8)) {
        pg8::Gemm g{F.H2, F.WFI, M, NFI, DM}; pg8::StaticOrder S; S.init(M, NFI, F.G, (int)blockIdx.x);
        pg8::EpiSwiGLU E{F.HID, DFF};
        pg8::gemm_phase<pg8::EpiSwiGLU, pg8::StaticOrder, true, true>(F.lds + RING_OFF, g, S, E);
        if (BOTH(8)) GRID_BAR();
    }
    if (IN(9)) {
        pg8::Gemm g{F.HID, F.WFO, M, DM, DFF}; pg8::StaticOrder S; S.init(M, DM, F.G, (int)blockIdx.x);
        pg8::EpiRes E{F.out, F.out, F.MOD + MOD_G2, NADA, ALPHA};
        pg8::gemm_phase<pg8::EpiRes, pg8::StaticOrder, true, true>(F.lds + RING_OFF, g, S, E);
        if (BOTH(9)) GRID_BAR();
    }
    if (IN(10)) { p10_ln_final(F); }
#undef IN
#undef BOTH
}

extern "C" void kernel_launch(void* const* d_in, const int* in_sizes, int n_in, void* d_out, int out_size, void* d_ws, size_t ws_size, hipStream_t stream) {
    static int grid = 0;
    if (grid == 0) {
        if (n_in != 12 || in_sizes[0] != M * DM || out_size != M * DM || ws_size < WS_END) {
            fprintf(stderr, "kernel_launch: shape mismatch (n_in %d, in0 %d, out %d, ws %zu; need ws >= %zu); nothing launched\n", n_in, n_in > 0 ? in_sizes[0] : -1, out_size, ws_size, (size_t)WS_END); grid = -1; return; }
        int dev = 0, cus = 0, per_cu = 0;
        if (hipGetDevice(&dev) != hipSuccess || hipDeviceGetAttribute(&cus, hipDeviceAttributeMultiprocessorCount, dev) != hipSuccess) { fprintf(stderr, "kernel_launch: device query failed\n"); grid = -1; return; }
        if (hipFuncSetAttribute((const void*)fwd_kernel, hipFuncAttributeMaxDynamicSharedMemorySize, LDS_BYTES) != hipSuccess) { fprintf(stderr, "kernel_launch: hipFuncSetAttribute failed\n"); grid = -1; return; }
        if (hipOccupancyMaxActiveBlocksPerMultiprocessor(&per_cu, (const void*)fwd_kernel, NWAVES * 64, LDS_BYTES) != hipSuccess || per_cu < 1)
            fprintf(stderr, "kernel_launch: note: occupancy query reports %d workgroups per CU\n", per_cu);
        (void)hipGetLastError();
        grid = cus;
        if (grid != 256) fprintf(stderr, "kernel_launch: note: %d CUs (built for 256)\n", grid);
    }
    if (grid < 0) return;
    if (hipMemsetAsync((char*)d_ws + WS_CTL, 0, CTL_ZERO_BYTES, stream) != hipSuccess) { fprintf(stderr, "kernel_launch: memset failed\n"); return; }
    Args a{};
    for (int i = 0; i < 12; ++i) a.in[i] = (const float*)d_in[i];
    a.out = (float*)d_out; a.ws = (unsigned char*)d_ws;
    for (int li = 0; li < N_LAUNCHES; ++li) {
        a.ph_lo = (N_LAUNCHES == 1) ? 0 : li; a.ph_hi = (N_LAUNCHES == 1) ? N_PHASES : li + 1;
        hipLaunchKernelGGL(fwd_kernel, dim3(grid), dim3(NWAVES * 64), LDS_BYTES, stream, a);
        const hipError_t le = hipPeekAtLastError();
        if (le != hipSuccess) { fprintf(stderr, "kernel_launch: launch %d failed: %s\n", li, hipGetErrorName(le)); break; }
    }
}
```
